# Optimizing an MI355X kernel written in HIP

```python
import math
import jax, jax.numpy as jnp
from jax import lax
import numpy as np

D_MODEL = 1024
BATCH = 4
SEQ = 8192
DEPTH = 1

PLE_DIM = 256
EPS = 1e-6
GDN_HEADS = 4
GDN_DK = 128
GDN_DV = 128
CONV_K = 4
CHUNK = 64
DIFF_HEADS = 4
DIFF_DH = 64
DIFF_DV = 2 * DIFF_DH
ROT_DIM = DIFF_DH // 4
ROPE_THETA = 500000.0
Q_BLOCK = 128
D_FF = 4 * D_MODEL

GDN_QK = GDN_HEADS * GDN_DK
GDN_V = GDN_HEADS * GDN_DV
DIFF_QK = DIFF_HEADS * 2 * DIFF_DH
DIFF_V = DIFF_HEADS * DIFF_DV
IN_SIZES = (GDN_QK, GDN_QK, GDN_V, GDN_V, GDN_HEADS, GDN_HEADS, DIFF_QK, DIFF_QK, DIFF_V, D_MODEL, D_MODEL)
D_IN = int(sum(IN_SIZES))
IN_SPLITS = tuple(int(s) for s in np.cumsum(IN_SIZES)[:-1])

kernel_name = 'hybrid_gdn_diffattn_gated_merge'


def rms_norm(x, gain):
    xf = x.astype(jnp.float32)
    y = xf * lax.rsqrt(jnp.mean(xf * xf, axis=-1, keepdims=True) + EPS)
    return (y * gain.astype(jnp.float32)).astype(x.dtype)


def l2_normalize(x):
    xf = x.astype(jnp.float32)
    return xf * lax.rsqrt(jnp.sum(xf * xf, axis=-1, keepdims=True) + EPS)


def causal_depthwise_conv(x, w):
    c = x.shape[-1]
    return lax.conv_general_dilated(
        x, w[:, None, :].astype(x.dtype), window_strides=(1,), padding=[(CONV_K - 1, 0)],
        dimension_numbers=('NWC', 'WIO', 'NWC'), feature_group_count=c)


def apply_partial_rotary(x, cos, sin):
    half = ROT_DIM // 2
    c = cos[:, :, None, None, :].astype(x.dtype)
    s = sin[:, :, None, None, :].astype(x.dtype)
    x1, x2, xp = x[..., :half], x[..., half:ROT_DIM], x[..., ROT_DIM:]
    return jnp.concatenate([x1 * c - x2 * s, x2 * c + x1 * s, xp], axis=-1)


def chunked_gated_delta_rule(q, k, v, g, beta):
    b, t, h, dk = q.shape
    dv = v.shape[-1]
    n = t // CHUNK

    def to_chunks(a):
        a = a.astype(jnp.float32).reshape((b, n, CHUNK, h) + a.shape[3:])
        return jnp.moveaxis(a, 3, 1)

    q = to_chunks(q) * (dk ** -0.5)
    k = to_chunks(k)
    v = to_chunks(v)
    beta = to_chunks(beta)
    g = jnp.cumsum(to_chunks(g), axis=-1)
    idx = jnp.arange(CHUNK)
    incl = idx[:, None] >= idx[None, :]
    strict = idx[:, None] > idx[None, :]
    gdiff = g[..., :, None] - g[..., None, :]
    decay = jnp.where(incl, jnp.exp(jnp.where(incl, gdiff, 0.0)), 0.0)
    kb = k * beta[..., None]
    lower = jnp.where(strict, jnp.einsum('bhncd,bhnsd->bhncs', kb, k) * decay, 0.0)
    eye = jnp.eye(CHUNK, dtype=jnp.float32)
    tmat = lax.linalg.triangular_solve(eye + lower, jnp.broadcast_to(eye, lower.shape),
                                       left_side=True, lower=True, unit_diagonal=True)
    u = jnp.einsum('bhncs,bhnsd->bhncd', tmat, v * beta[..., None])
    w = jnp.einsum('bhncs,bhnsd->bhncd', tmat, kb * jnp.exp(g)[..., None])
    a_intra = jnp.einsum('bhncd,bhnsd->bhncs', q, k) * decay
    g_last = g[..., -1]
    q_dec = q * jnp.exp(g)[..., None]
    k_dec = k * jnp.exp(g_last[..., None] - g)[..., None]

    def step(state, xs):
        q_i, k_i, u_i, w_i, a_i, gl_i = xs
        v_new = u_i - jnp.einsum('bhck,bhkv->bhcv', w_i, state)
        o_i = jnp.einsum('bhck,bhkv->bhcv', q_i, state) + jnp.einsum('bhcs,bhsv->bhcv', a_i, v_new)
        state = state * jnp.exp(gl_i)[..., None, None] + jnp.einsum('bhck,bhcv->bhkv', k_i, v_new)
        return state, o_i

    xs = tuple(jnp.moveaxis(a, 2, 0) for a in (q_dec, k_dec, u, w, a_intra, g_last))
    s0 = jnp.zeros((b, h, dk, dv), jnp.float32)
    _, o = lax.scan(step, s0, xs)
    o = jnp.moveaxis(o, 0, 2)
    return jnp.moveaxis(o, 1, 3).reshape(b, t, h, dv)


def diff_attention(q, k, v, lam):
    b, t, h, _, dh = q.shape
    nb = t // Q_BLOCK
    qf = q.astype(jnp.float32) * (dh ** -0.5)
    qb = jnp.moveaxis(qf.reshape(b, nb, Q_BLOCK, h, 2, dh), 1, 0)
    kf = k.astype(jnp.float32)
    vf = v.astype(jnp.float32)
    key_idx = jnp.arange(t)

    def block(args):
        q_blk, blk = args
        q_idx = blk * Q_BLOCK + jnp.arange(Q_BLOCK)
        s = jnp.einsum('bqhcd,bkhcd->bhcqk', q_blk, kf)
        mask = key_idx[None, :] <= q_idx[:, None]
        pr = jax.nn.softmax(jnp.where(mask, s, -jnp.inf), axis=-1)
        a = pr[:, :, 0] - lam * pr[:, :, 1]
        return jnp.einsum('bhqk,bkhv->bqhv', a, vf)

    o = lax.map(block, (qb, jnp.arange(nb)))
    return jnp.moveaxis(o, 0, 1).reshape(b, t, h, v.shape[-1])


def setup_inputs(seed: int = 0) -> dict:
    key = jax.random.key(seed)
    ks = jax.random.split(key, 26)

    def nrm(k, shape, scale):
        return jax.random.normal(k, shape, jnp.float32) * scale

    def gain(k, shape):
        return 1.0 + 0.1 * jax.random.normal(k, shape, jnp.float32)

    offsets = jax.random.randint(ks[2], (BATCH, 1), 0, 1024, dtype=jnp.int32)
    positions = offsets + jnp.arange(SEQ, dtype=jnp.int32)[None, :]
    dt = jnp.exp(jax.random.uniform(ks[7], (DEPTH, GDN_HEADS), jnp.float32)
                 * (math.log(0.1) - math.log(0.001)) + math.log(0.001))
    dt_bias = dt + jnp.log(-jnp.expm1(-dt))
    a_log = jnp.log(jax.random.uniform(ks[6], (DEPTH, GDN_HEADS), jnp.float32, 1.0, 16.0))
    return {
        'x': nrm(ks[0], (BATCH, SEQ, D_MODEL), 1.0),
        'p': nrm(ks[1], (DEPTH, BATCH, SEQ, PLE_DIM), 1.0),
        'positions': positions,
        'attn_norm': gain(ks[3], (DEPTH, D_MODEL)),
        'w_in': nrm(ks[4], (DEPTH, D_MODEL, D_IN), D_MODEL ** -0.5),
        'conv_w': nrm(ks[5], (DEPTH, CONV_K, GDN_QK * 2 + GDN_V), CONV_K ** -0.5),
        'a_log': a_log,
        'dt_bias': dt_bias,
        'gdn_norm': gain(ks[8], (DEPTH, GDN_DV)),
        'w_o_a': nrm(ks[9], (DEPTH, GDN_V, D_MODEL), GDN_V ** -0.5),
        'q_norm': gain(ks[10], (DEPTH, DIFF_DH)),
        'k_norm': gain(ks[11], (DEPTH, DIFF_DH)),
        'lambda_q1': nrm(ks[12], (DEPTH, DIFF_DH), 0.1),
        'lambda_k1': nrm(ks[13], (DEPTH, DIFF_DH), 0.1),
        'lambda_q2': nrm(ks[14], (DEPTH, DIFF_DH), 0.1),
        'lambda_k2': nrm(ks[15], (DEPTH, DIFF_DH), 0.1),
        'diff_norm': gain(ks[16], (DEPTH, DIFF_DV)),
        'w_o_b': nrm(ks[17], (DEPTH, DIFF_V, D_MODEL), DIFF_V ** -0.5),
        'w_out': nrm(ks[18], (DEPTH, D_MODEL, D_MODEL), D_MODEL ** -0.5),
        'mlp_norm': gain(ks[19], (DEPTH, D_MODEL)),
        'w_up': nrm(ks[20], (DEPTH, D_MODEL, D_FF), D_MODEL ** -0.5),
        'w_down': nrm(ks[21], (DEPTH, D_FF, D_MODEL), D_FF ** -0.5),
        'ple_norm': gain(ks[22], (DEPTH, D_MODEL)),
        'w_ple_gate': nrm(ks[23], (DEPTH, D_MODEL, D_MODEL), D_MODEL ** -0.5),
        'w_ple': nrm(ks[24], (DEPTH, PLE_DIM, D_MODEL), PLE_DIM ** -0.5),
    }


def reference(x, p, positions, attn_norm, w_in, conv_w, a_log, dt_bias, gdn_norm, w_o_a,
              q_norm, k_norm, lambda_q1, lambda_k1, lambda_q2, lambda_k2, diff_norm, w_o_b,
              w_out, mlp_norm, w_up, w_down, ple_norm, w_ple_gate, w_ple):
    b, t, _ = x.shape
    inv_freq = ROPE_THETA ** (-jnp.arange(0, ROT_DIM, 2, dtype=jnp.float32) / ROT_DIM)
    ang = positions.astype(jnp.float32)[..., None] * inv_freq
    cos, sin = jnp.cos(ang), jnp.sin(ang)

    for i in range(DEPTH):
        h = rms_norm(x, attn_norm[i])
        proj = h @ w_in[i].astype(x.dtype)
        (a_q, a_k, a_v, a_z, a_a, a_b, b_q, b_k, b_v, gate_a, gate_b) = jnp.split(proj, IN_SPLITS, axis=-1)

        qkv = jax.nn.silu(causal_depthwise_conv(jnp.concatenate([a_q, a_k, a_v], axis=-1), conv_w[i]))
        cq, ck, cv = jnp.split(qkv, [GDN_QK, 2 * GDN_QK], axis=-1)
        cq = l2_normalize(cq.reshape(b, t, GDN_HEADS, GDN_DK))
        ck = l2_normalize(ck.reshape(b, t, GDN_HEADS, GDN_DK))
        cv = cv.reshape(b, t, GDN_HEADS, GDN_DV)
        g = -jnp.exp(a_log[i].astype(jnp.float32)) * jax.nn.softplus(
            a_a.astype(jnp.float32) + dt_bias[i].astype(jnp.float32))
        beta = jax.nn.sigmoid(a_b.astype(jnp.float32))
        o_a = chunked_gated_delta_rule(cq, ck, cv, g, beta)
        o_a = rms_norm(o_a, gdn_norm[i]) * jax.nn.silu(
            a_z.reshape(b, t, GDN_HEADS, GDN_DV).astype(jnp.float32))
        y_a = o_a.reshape(b, t, GDN_V).astype(x.dtype) @ w_o_a[i].astype(x.dtype)

        bq = rms_norm(b_q.reshape(b, t, DIFF_HEADS, 2, DIFF_DH), q_norm[i])
        bk = rms_norm(b_k.reshape(b, t, DIFF_HEADS, 2, DIFF_DH), k_norm[i])
        bq = apply_partial_rotary(bq, cos, sin)
        bk = apply_partial_rotary(bk, cos, sin)
        lam_init = 0.8 - 0.6 * math.exp(-0.3 * i)
        lam = (jnp.exp(jnp.sum(lambda_q1[i].astype(jnp.float32) * lambda_k1[i].astype(jnp.float32)))
               - jnp.exp(jnp.sum(lambda_q2[i].astype(jnp.float32) * lambda_k2[i].astype(jnp.float32)))
               + lam_init)
        o_b = diff_attention(bq, bk, b_v.reshape(b, t, DIFF_HEADS, DIFF_DV), lam)
        o_b = rms_norm(o_b, diff_norm[i]) * (1.0 - lam_init)
        y_b = o_b.reshape(b, t, DIFF_V).astype(x.dtype) @ w_o_b[i].astype(x.dtype)

        merged = jax.nn.sigmoid(gate_a) * y_a + jax.nn.sigmoid(gate_b) * y_b
        x = x + merged @ w_out[i].astype(x.dtype)

        h = rms_norm(x, mlp_norm[i])
        x = x + jnp.square(jax.nn.relu(h @ w_up[i].astype(x.dtype))) @ w_down[i].astype(x.dtype)

        gate = jax.nn.sigmoid(rms_norm(x, ple_norm[i]) @ w_ple_gate[i].astype(x.dtype))
        x = x + gate * (p[i].astype(x.dtype) @ w_ple[i].astype(x.dtype))
    return x
```

```cpp
#include <hip/hip_runtime.h>
#include <hip/hip_cooperative_groups.h>
#include <cstdio>
#include <cstdint>
namespace cg = cooperative_groups;
namespace pg8 {
#define PG8_LAS __attribute__((address_space(3)))
typedef unsigned short bf16_t;
typedef short bf16x8 __attribute__((ext_vector_type(8)));
typedef float f32x4 __attribute__((ext_vector_type(4)));
typedef unsigned u32x4 __attribute__((ext_vector_type(4)));
constexpr int BM = 256, BK = 64, HALF = 128, HTB = HALF * BK * 2  , STAGE_BYTES = 8 * HTB, NXCD = 8, WGM = 8;

__host__ __device__ __forceinline__ int lds_byte(int r, int c) { const int st = (r >> 4) * 2 + (c >> 5), rr = r & 15, cc = c & 31, ob = rr * 64 + cc * 2; return st * 1024 + (ob ^ (((ob >> 9) & 1) << 5)); }
__host__ __device__ __forceinline__ void stage_rc(int b, int& R, int& C) { const int st = b / 1024, sb = b % 1024, swz = sb ^ (((sb >> 9) & 1) << 5); R = (st >> 1) * 16 + swz / 64; C = (st & 1) * 32 + (swz % 64) / 2; }
__host__ __device__ __forceinline__ int perm32(int rho) { const int n = rho >> 4, i = rho & 15; return 8 * (i >> 2) + 4 * n + (i & 3); }

struct Unit { int pm, pn; };
struct Gemm { const bf16_t* A; const bf16_t* Bt; int M, N, K; };

struct StaticOrder {
    int nM, nN, nwg, G, c;
    __host__ __device__ void init(int M, int N, int G_, int c_) { nM = M / BM; nN = N / BM; nwg = nM * nN; G = G_; c = c_; }
    __host__ __device__ bool next(int i, Unit& u) const {
        const long L = (long)i * G + c; if (L >= nwg) return false;
        int wgid = (int)L; { const int q = nwg / NXCD, r = nwg % NXCD, xcd = wgid % NXCD, off = wgid / NXCD; wgid = (xcd < r ? xcd * (q + 1) : r * (q + 1) + (xcd - r) * q) + off; }
        const int nig = WGM * nN, gid = wgid / nig, fm = gid * WGM, gsz = (nM - fm) < WGM ? (nM - fm) : WGM;
        u.pm = fm + ((wgid % nig) % gsz); u.pn = (wgid % nig) / gsz; return true;
    }
    __device__ __forceinline__ void a_ready(const Unit&) const {}
    __device__ __forceinline__ void done(const Unit&) const {}
};

__device__ __forceinline__ unsigned cvt_pk_bf16(float lo, float hi) { unsigned r; asm volatile("v_cvt_pk_bf16_f32 %0, %1, %2" : "=v"(r) : "v"(lo), "v"(hi)); return r; }
typedef float f32x2 __attribute__((ext_vector_type(2)));
constexpr int EM = 32768;
constexpr size_t ESEG = (size_t)EM * 512;
__device__ __forceinline__ float bf2f(unsigned short b) { return __uint_as_float((unsigned)b << 16); }
__device__ __forceinline__ float bflo(unsigned w) { return __uint_as_float(w << 16); }
__device__ __forceinline__ float bfhi(unsigned w) { return __uint_as_float(w & 0xffff0000u); }
__device__ __forceinline__ float sigm(float x) { return 1.0f / (1.0f + __expf(-x)); }
__device__ __forceinline__ u32x4 pack8(const f32x4& v0, const f32x4& v1) { u32x4 w; w.x = cvt_pk_bf16(v0[0], v0[1]); w.y = cvt_pk_bf16(v0[2], v0[3]); w.z = cvt_pk_bf16(v1[0], v1[1]); w.w = cvt_pk_bf16(v1[2], v1[3]); return w; }
__device__ __forceinline__ void unpack8(const u32x4& w, f32x4& v0, f32x4& v1) { v0 = (f32x4){bflo(w.x), bfhi(w.x), bflo(w.y), bfhi(w.y)}; v1 = (f32x4){bflo(w.z), bfhi(w.z), bflo(w.w), bfhi(w.w)}; }

struct EpiSplit {
    static constexpr bool PERM = true, AFTER_DRAIN = false;
    bf16_t* O;
    __device__ __forceinline__ void operator()(const f32x4 (&acc)[2][2][4][2], const Unit& u, int wr, int wc, int fr, int fq) const {
        const int row0 = u.pm * BM + wr * 64 + fr; const int colt = u.pn * BM; const int seg = colt >> 9, cin = colt & 511;
        bf16_t* base = O + (size_t)seg * ESEG + cin + wc * 32 + 8 * fq;
#pragma unroll
        for (int ai = 0; ai < 2; ++ai)
#pragma unroll
            for (int m = 0; m < 4; ++m) { asm volatile("" ::: "memory"); bf16_t* rowp = base + (size_t)(row0 + ai * HALF + m * 16) * 512;
#pragma unroll
                for (int bj = 0; bj < 2; ++bj) *(u32x4*)(rowp + bj * HALF) = pack8(acc[ai][bj][m][0], acc[ai][bj][m][1]); }
    }
};
template <bool ADD> struct EpiGate {
    static constexpr bool PERM = true, AFTER_DRAIN = false;
    const bf16_t* G; bf16_t* Tt;
    __device__ __forceinline__ void operator()(const f32x4 (&acc)[2][2][4][2], const Unit& u, int wr, int wc, int fr, int fq) const {
        const int row0 = u.pm * BM + wr * 64 + fr; const int colt = u.pn * BM; const int seg = colt >> 9, cin = colt & 511;
        const bf16_t* gbase = G + (size_t)seg * ESEG + cin + wc * 32 + 8 * fq;
        bf16_t* tbase = Tt + colt + wc * 32 + 8 * fq;
#pragma unroll
        for (int ai = 0; ai < 2; ++ai)
#pragma unroll
            for (int m = 0; m < 4; ++m) { asm volatile("" ::: "memory"); const size_t row = (size_t)(row0 + ai * HALF + m * 16);
#pragma unroll
                for (int bj = 0; bj < 2; ++bj) {
                    const u32x4 gw = *(const u32x4*)(gbase + row * 512 + bj * HALF); f32x4 g0, g1; unpack8(gw, g0, g1);
                    f32x4 v0 = acc[ai][bj][m][0], v1 = acc[ai][bj][m][1];
#pragma unroll
                    for (int e = 0; e < 4; ++e) { v0[e] *= sigm(g0[e]); v1[e] *= sigm(g1[e]); }
                    bf16_t* tp = tbase + row * 1024 + bj * HALF;
                    if (ADD) { const u32x4 tw = *(const u32x4*)tp; f32x4 t0, t1; unpack8(tw, t0, t1); v0 += t0; v1 += t1; }
                    *(u32x4*)tp = pack8(v0, v1); } }
    }
};
struct EpiRes {
    static constexpr bool PERM = true, AFTER_DRAIN = false;
    const float* base; float* out; bf16_t* XB; float* SS;
    __device__ __forceinline__ void operator()(const f32x4 (&acc)[2][2][4][2], const Unit& u, int wr, int wc, int fr, int fq) const {
        const int row0 = u.pm * BM + wr * 64 + fr; const int col0 = u.pn * BM + wc * 32 + 8 * fq;
#pragma unroll
        for (int ai = 0; ai < 2; ++ai)
#pragma unroll
            for (int m = 0; m < 4; ++m) { asm volatile("" ::: "memory"); const size_t row = (size_t)(row0 + ai * HALF + m * 16); float ss = 0.f;
#pragma unroll
                for (int bj = 0; bj < 2; ++bj) { const size_t off = row * 1024 + col0 + bj * HALF;
                    const f32x4 b0 = *(const f32x4*)(base + off), b1 = *(const f32x4*)(base + off + 4);
                    const f32x4 v0 = acc[ai][bj][m][0] + b0, v1 = acc[ai][bj][m][1] + b1;
                    *(f32x4*)(out + off) = v0; *(f32x4*)(out + off + 4) = v1;
                    *(u32x4*)(XB + off) = pack8(v0, v1);
                    ss += (v0[0] * v0[0] + v0[1] * v0[1]) + (v0[2] * v0[2] + v0[3] * v0[3]) + (v1[0] * v1[0] + v1[1] * v1[1]) + (v1[2] * v1[2] + v1[3] * v1[3]); }
                ss += __shfl_xor(ss, 16); ss += __shfl_xor(ss, 32);
                if (fq == 0) atomicAdd(SS + row, ss); }
    }
};
struct EpiUp {
    static constexpr bool PERM = true, AFTER_DRAIN = false;
    bf16_t* U; const float* SS;
    __device__ __forceinline__ void operator()(const f32x4 (&acc)[2][2][4][2], const Unit& u, int wr, int wc, int fr, int fq) const {
        const int row0 = u.pm * BM + wr * 64 + fr; const int col0 = u.pn * BM + wc * 32 + 8 * fq;
#pragma unroll
        for (int ai = 0; ai < 2; ++ai)
#pragma unroll
            for (int m = 0; m < 4; ++m) { asm volatile("" ::: "memory"); const size_t row = (size_t)(row0 + ai * HALF + m * 16);
                const float rstd = rsqrtf(SS[row] * (1.0f / 1024.0f) + 1e-6f);
#pragma unroll
                for (int bj = 0; bj < 2; ++bj) { f32x4 v0 = acc[ai][bj][m][0] * rstd, v1 = acc[ai][bj][m][1] * rstd;
#pragma unroll
                    for (int e = 0; e < 4; ++e) { const float a = fmaxf(v0[e], 0.f), b = fmaxf(v1[e], 0.f); v0[e] = a * a; v1[e] = b * b; }
                    *(u32x4*)(U + row * 4096 + col0 + bj * HALF) = pack8(v0, v1); } }
    }
};
struct EpiF32 {
    static constexpr bool PERM = false, AFTER_DRAIN = false;
    float* O;
    __device__ __forceinline__ void operator()(const f32x4 (&acc)[2][2][4][2], const Unit& u, int wr, int wc, int fr, int fq) const {
        const int row0 = u.pm * BM + wr * 64 + fr; const int col0 = u.pn * BM + wc * 32 + 4 * fq;
#pragma unroll
        for (int ai = 0; ai < 2; ++ai)
#pragma unroll
            for (int m = 0; m < 4; ++m) { asm volatile("" ::: "memory"); const size_t row = (size_t)(row0 + ai * HALF + m * 16);
#pragma unroll
                for (int bj = 0; bj < 2; ++bj)
#pragma unroll
                    for (int n = 0; n < 2; ++n) *(f32x4*)(O + row * 1024 + col0 + bj * HALF + n * 16) = acc[ai][bj][m][n]; }
    }
};
struct EpiPle {
    static constexpr bool PERM = false, AFTER_DRAIN = false;
    float* out; const float* P; const float* SS;
    __device__ __forceinline__ void operator()(const f32x4 (&acc)[2][2][4][2], const Unit& u, int wr, int wc, int fr, int fq) const {
        const int row0 = u.pm * BM + wr * 64 + fr; const int col0 = u.pn * BM + wc * 32 + 4 * fq;
#pragma unroll
        for (int ai = 0; ai < 2; ++ai)
#pragma unroll
            for (int m = 0; m < 4; ++m) { asm volatile("" ::: "memory"); const size_t row = (size_t)(row0 + ai * HALF + m * 16);
                const float rstd = rsqrtf(SS[row] * (1.0f / 1024.0f) + 1e-6f);
#pragma unroll
                for (int bj = 0; bj < 2; ++bj)
#pragma unroll
                    for (int n = 0; n < 2; ++n) { const size_t off = row * 1024 + col0 + bj * HALF + n * 16;
                        const f32x4 x = *(const f32x4*)(out + off), pl = *(const f32x4*)(P + off); f32x4 v = acc[ai][bj][m][n] * rstd;
#pragma unroll
                        for (int e = 0; e < 4; ++e) v[e] = x[e] + sigm(v[e]) * pl[e];
                        *(f32x4*)(out + off) = v; } }
    }
};

template <bool BASE_BF16> struct EpiResB {
    static constexpr bool PERM = true, AFTER_DRAIN = false;
    const void* base; bf16_t* XB; float* SS;
    __device__ __forceinline__ void operator()(const f32x4 (&acc)[2][2][4][2], const Unit& u, int wr, int wc, int fr, int fq) const {
        const int row0 = u.pm * BM + wr * 64 + fr; const int col0 = u.pn * BM + wc * 32 + 8 * fq;
#pragma unroll
        for (int ai = 0; ai < 2; ++ai)
#pragma unroll
            for (int m = 0; m < 4; ++m) { asm volatile("" ::: "memory"); const size_t row = (size_t)(row0 + ai * HALF + m * 16); float ss = 0.f;
#pragma unroll
                for (int bj = 0; bj < 2; ++bj) { const size_t off = row * 1024 + col0 + bj * HALF; f32x4 b0, b1;
                    if (BASE_BF16) { const u32x4 bw = *(const u32x4*)((const bf16_t*)base + off); unpack8(bw, b0, b1); }
                    else { b0 = *(const f32x4*)((const float*)base + off); b1 = *(const f32x4*)((const float*)base + off + 4); }
                    const f32x4 v0 = acc[ai][bj][m][0] + b0, v1 = acc[ai][bj][m][1] + b1;
                    *(u32x4*)(XB + off) = pack8(v0, v1);
                    ss += (v0[0] * v0[0] + v0[1] * v0[1]) + (v0[2] * v0[2] + v0[3] * v0[3]) + (v1[0] * v1[0] + v1[1] * v1[1]) + (v1[2] * v1[2] + v1[3] * v1[3]); }
                ss += __shfl_xor(ss, 16); ss += __shfl_xor(ss, 32);
                if (fq == 0) atomicAdd(SS + row, ss); }
    }
};
struct EpiBf {
    static constexpr bool PERM = true, AFTER_DRAIN = false;
    bf16_t* O;
    __device__ __forceinline__ void operator()(const f32x4 (&acc)[2][2][4][2], const Unit& u, int wr, int wc, int fr, int fq) const {
        const int row0 = u.pm * BM + wr * 64 + fr; const int col0 = u.pn * BM + wc * 32 + 8 * fq;
#pragma unroll
        for (int ai = 0; ai < 2; ++ai)
#pragma unroll
            for (int m = 0; m < 4; ++m) { asm volatile("" ::: "memory"); const size_t row = (size_t)(row0 + ai * HALF + m * 16);
#pragma unroll
                for (int bj = 0; bj < 2; ++bj) *(u32x4*)(O + row * 1024 + col0 + bj * HALF) = pack8(acc[ai][bj][m][0], acc[ai][bj][m][1]); }
    }
};
struct EpiPleB {
    static constexpr bool PERM = true, AFTER_DRAIN = false;
    float* out; const bf16_t* XB; const bf16_t* P; const float* SS;
    __device__ __forceinline__ void operator()(const f32x4 (&acc)[2][2][4][2], const Unit& u, int wr, int wc, int fr, int fq) const {
        const int row0 = u.pm * BM + wr * 64 + fr; const int col0 = u.pn * BM + wc * 32 + 8 * fq;
#pragma unroll
        for (int ai = 0; ai < 2; ++ai)
#pragma unroll
            for (int m = 0; m < 4; ++m) { asm volatile("" ::: "memory"); const size_t row = (size_t)(row0 + ai * HALF + m * 16);
                const float rstd = rsqrtf(SS[row] * (1.0f / 1024.0f) + 1e-6f);
#pragma unroll
                for (int bj = 0; bj < 2; ++bj) { const size_t off = row * 1024 + col0 + bj * HALF;
                    const u32x4 xw = *(const u32x4*)(XB + off), pw = *(const u32x4*)(P + off); f32x4 x0, x1, p0, p1; unpack8(xw, x0, x1); unpack8(pw, p0, p1);
                    f32x4 v0 = acc[ai][bj][m][0] * rstd, v1 = acc[ai][bj][m][1] * rstd;
#pragma unroll
                    for (int e2 = 0; e2 < 4; ++e2) { v0[e2] = x0[e2] + sigm(v0[e2]) * p0[e2]; v1[e2] = x1[e2] + sigm(v1[e2]) * p1[e2]; }
                    *(f32x4*)(out + off) = v0; *(f32x4*)(out + off + 4) = v1; } }
    }
};
template <class Epi, class Sched, bool ALIGN_EPI = false, bool SP2 = false>
__device__ __forceinline__ void gemm_phase(PG8_LAS unsigned char* lds, const Gemm g, const Sched& S, const Epi& E) {
    int tid_ = threadIdx.x; asm volatile("" : "+v"(tid_)); const int tid = tid_, wid = __builtin_amdgcn_readfirstlane(tid >> 6), lane = tid & 63, wr = wid >> 2, wc = wid & 3, fr = lane & 15, fq = lane >> 4;
    const int K = g.K, nt = K / BK;
    unsigned voffA[2], voffB[2];
#pragma unroll
    for (int i = 0; i < 2; ++i) { int R, C; stage_rc(tid * 16 + i * 8192, R, C); const int Rb = Epi::PERM ? ((R & ~31) + perm32(R & 31)) : R;
        voffA[i] = (unsigned)(R * K + C) * 2u; voffB[i] = (unsigned)(Rb * K + C) * 2u; }
    const size_t kstep = (size_t)(BK * 2);
    const size_t hstep = (size_t)HALF * K * 2;
    const size_t tstep = 2 * hstep;
    const unsigned ldsw = (unsigned)wid * 1024u;
    const int aoff = lds_byte(wr * 64 + fr, fq * 8), boff = lds_byte(wc * 32 + fr, fq * 8);
#define PG8_SA(b, h) (((b) * 2 + (h)) * HTB)
#define PG8_SB(b, h) ((4 + (b) * 2 + (h)) * HTB)
#define PG8_STAGE(bufoff, gbase, voff) do { _Pragma("unroll") for (int _i = 0; _i < 2; ++_i) \
        __builtin_amdgcn_global_load_lds((const unsigned*)((const char*)(gbase) + (voff)[_i]), (PG8_LAS unsigned*)(lds + (bufoff) + ldsw + _i * 8192), 16, 0, 0); } while (0)
#define PG8_LDA(dst, b, h) do { _Pragma("unroll") for (int m = 0; m < 4; ++m) _Pragma("unroll") for (int k = 0; k < 2; ++k) dst[m][k] = *(const PG8_LAS bf16x8*)(lds + PG8_SA(b, h) + aoff + m * 2048 + k * 1024); } while (0)
#define PG8_LDB(dst, b, h) do { _Pragma("unroll") for (int n = 0; n < 2; ++n) _Pragma("unroll") for (int k = 0; k < 2; ++k) dst[n][k] = *(const PG8_LAS bf16x8*)(lds + PG8_SB(b, h) + boff + n * 2048 + k * 1024); } while (0)
#define PG8_MMA(ai, bj, At, Bt) do { __builtin_amdgcn_s_setprio(1); _Pragma("unroll") for (int m = 0; m < 4; ++m) _Pragma("unroll") for (int n = 0; n < 2; ++n) _Pragma("unroll") for (int k = 0; k < 2; ++k) \
        acc[ai][bj][m][n] = __builtin_amdgcn_mfma_f32_16x16x32_bf16(Bt[n][k], At[m][k], acc[ai][bj][m][n], 0, 0, 0); __builtin_amdgcn_s_setprio(0); } while (0)
#define PG8_WAIT_V(n) asm volatile("s_waitcnt vmcnt(" #n ")" ::: "memory")
#define PG8_WAIT_L(n) asm volatile("s_waitcnt lgkmcnt(" #n ")" ::: "memory")
#define PG8_BAR __builtin_amdgcn_s_barrier()
#define PG8_SCHED __builtin_amdgcn_sched_barrier(0)
    Unit cur, nxt; int ui = 0;
    if (!S.next(0, cur)) return;
    f32x4 acc[2][2][4][2];
#pragma unroll
    for (int a = 0; a < 2; ++a)
#pragma unroll
        for (int b = 0; b < 2; ++b)
#pragma unroll
            for (int m = 0; m < 4; ++m)
#pragma unroll
                for (int n = 0; n < 2; ++n) acc[a][b][m][n] = (f32x4){0.f, 0.f, 0.f, 0.f};
    bf16x8 At[4][2], B0[2][2], B1[2][2];
    const char* cA = (const char*)g.A + (size_t)cur.pm * tstep; const char* cB = (const char*)g.Bt + (size_t)cur.pn * tstep;
    S.a_ready(cur);
    if constexpr (SP2) {
        PG8_STAGE(PG8_SB(0, 0), cB, voffB); PG8_STAGE(PG8_SB(0, 1), cB + hstep, voffB); PG8_STAGE(PG8_SA(0, 0), cA, voffA); PG8_STAGE(PG8_SA(0, 1), cA + hstep, voffA);
        if (wr == 1) PG8_BAR;
        PG8_WAIT_V(2); PG8_BAR;
        PG8_STAGE(PG8_SB(1, 0), cB + kstep, voffB); PG8_STAGE(PG8_SA(1, 0), cA + kstep, voffA); PG8_STAGE(PG8_SB(1, 1), cB + hstep + kstep, voffB);
        PG8_WAIT_V(6); PG8_BAR;
    } else {
        PG8_STAGE(PG8_SB(0, 0), cB, voffB); PG8_STAGE(PG8_SA(0, 0), cA, voffA); PG8_STAGE(PG8_SB(0, 1), cB + hstep, voffB); PG8_STAGE(PG8_SA(0, 1), cA + hstep, voffA);
        if (wr == 1) PG8_BAR;
        PG8_WAIT_V(4); PG8_BAR;
        PG8_STAGE(PG8_SB(1, 0), cB + kstep, voffB); PG8_STAGE(PG8_SA(1, 0), cA + kstep, voffA); PG8_STAGE(PG8_SB(1, 1), cB + hstep + kstep, voffB);
        PG8_WAIT_V(6); PG8_BAR;
    }
    for (;;) {
        const bool has_next = S.next(ui + 1, nxt);
        const char* nA = has_next ? (const char*)g.A + (size_t)nxt.pm * tstep : cA; const char* nB = has_next ? (const char*)g.Bt + (size_t)nxt.pn * tstep : cB;
        for (int t = 0; t < nt; t += 2) {
            const bool last = (t == nt - 2);
            const char* a1 = cA + (size_t)(t + 1) * kstep;
            const char* a2 = last ? nA : cA + (size_t)(t + 2) * kstep; const char* b2 = last ? nB : cB + (size_t)(t + 2) * kstep;
            const char* a3 = a2 + kstep; const char* b3 = b2 + kstep;
            if (last && has_next) S.a_ready(nxt);
            if constexpr (SP2) {
            PG8_LDB(B0, 0, 0); PG8_LDB(B1, 0, 1); PG8_SCHED; PG8_LDA(At, 0, 0); PG8_STAGE(PG8_SA(1, 1), a1 + hstep, voffA);
            PG8_WAIT_V(8); PG8_WAIT_L(0); PG8_BAR; PG8_MMA(0, 0, At, B0); PG8_MMA(0, 1, At, B1); PG8_BAR; PG8_SCHED;
            PG8_LDA(At, 0, 1); PG8_STAGE(PG8_SB(0, 0), b2, voffB); PG8_STAGE(PG8_SB(0, 1), b2 + hstep, voffB); PG8_STAGE(PG8_SA(0, 0), a2, voffA);
            PG8_WAIT_V(8); PG8_WAIT_L(0); PG8_BAR; PG8_MMA(1, 0, At, B0); PG8_MMA(1, 1, At, B1); PG8_BAR; PG8_SCHED;
            PG8_LDB(B0, 1, 0); PG8_LDB(B1, 1, 1); PG8_SCHED; PG8_LDA(At, 1, 0); PG8_STAGE(PG8_SA(0, 1), a2 + hstep, voffA);
            PG8_WAIT_V(8); PG8_WAIT_L(0); PG8_BAR; PG8_MMA(0, 0, At, B0); PG8_MMA(0, 1, At, B1); PG8_BAR; PG8_SCHED;
            PG8_LDA(At, 1, 1); PG8_STAGE(PG8_SB(1, 0), b3, voffB); PG8_STAGE(PG8_SB(1, 1), b3 + hstep, voffB); PG8_STAGE(PG8_SA(1, 0), a3, voffA);
            PG8_WAIT_V(8); PG8_WAIT_L(0); PG8_BAR; PG8_MMA(1, 0, At, B0); PG8_MMA(1, 1, At, B1); PG8_BAR; PG8_SCHED;
            } else {
            PG8_LDB(B0, 0, 0); PG8_SCHED; PG8_LDA(At, 0, 0); PG8_STAGE(PG8_SA(1, 1), a1 + hstep, voffA);
            PG8_WAIT_L(8); PG8_BAR; PG8_WAIT_L(0); PG8_MMA(0, 0, At, B0); PG8_BAR; PG8_SCHED;
            PG8_LDB(B1, 0, 1); PG8_STAGE(PG8_SB(0, 0), b2, voffB);
            PG8_BAR; PG8_WAIT_L(0); PG8_MMA(0, 1, At, B1); PG8_BAR;
            PG8_LDA(At, 0, 1); PG8_STAGE(PG8_SA(0, 0), a2, voffA);
            PG8_BAR; PG8_WAIT_L(0); PG8_MMA(1, 0, At, B0); PG8_BAR; PG8_SCHED;
            PG8_STAGE(PG8_SB(0, 1), b2 + hstep, voffB);
            PG8_WAIT_V(6); PG8_BAR; PG8_MMA(1, 1, At, B1); PG8_BAR;
            PG8_LDB(B0, 1, 0); PG8_SCHED; PG8_LDA(At, 1, 0); PG8_STAGE(PG8_SA(0, 1), a2 + hstep, voffA);
            PG8_WAIT_L(8); PG8_BAR; PG8_WAIT_L(0); PG8_MMA(0, 0, At, B0); PG8_BAR; PG8_SCHED;
            PG8_LDB(B1, 1, 1); PG8_STAGE(PG8_SB(1, 0), b3, voffB);
            PG8_BAR; PG8_WAIT_L(0); PG8_MMA(0, 1, At, B1); PG8_BAR;
            PG8_LDA(At, 1, 1); PG8_STAGE(PG8_SA(1, 0), a3, voffA);
            PG8_BAR; PG8_WAIT_L(0); PG8_MMA(1, 0, At, B0); PG8_BAR; PG8_SCHED;
            PG8_STAGE(PG8_SB(1, 1), b3 + hstep, voffB);
            PG8_WAIT_V(6); PG8_BAR; PG8_MMA(1, 1, At, B1); PG8_BAR;
            }
        }
        if constexpr (ALIGN_EPI) { if (wr == 0) PG8_BAR; }
        if constexpr (!Epi::AFTER_DRAIN) { E(acc, cur, wr, wc, fr, fq); S.done(cur); }
        if (!has_next) break;
#pragma unroll
        for (int a = 0; a < 2; ++a)
#pragma unroll
            for (int b = 0; b < 2; ++b)
#pragma unroll
                for (int m = 0; m < 4; ++m)
#pragma unroll
                    for (int n = 0; n < 2; ++n) acc[a][b][m][n] = (f32x4){0.f, 0.f, 0.f, 0.f};
        cur = nxt; cA = nA; cB = nB; ++ui;
        if constexpr (ALIGN_EPI) { if (wr == 1) PG8_BAR; }
    }
    PG8_WAIT_V(0);
    if constexpr (!ALIGN_EPI) { if (wr == 0) PG8_BAR; }
    PG8_BAR;
    if constexpr (Epi::AFTER_DRAIN) { E.fused(acc, cur, wr, wc, fr, fq, lds, wid, lane); S.done(cur); }
#undef PG8_SA
#undef PG8_SB
#undef PG8_STAGE
#undef PG8_LDA
#undef PG8_LDB
#undef PG8_MMA
#undef PG8_WAIT_V
#undef PG8_WAIT_L
#undef PG8_BAR
#undef PG8_SCHED
}
}

#define LAS __attribute__((address_space(3)))
typedef unsigned short bf16;
typedef unsigned v4u __attribute__((ext_vector_type(4)));
typedef unsigned v2u __attribute__((ext_vector_type(2)));
typedef float f32x4 __attribute__((ext_vector_type(4)));
typedef float f32x16 __attribute__((ext_vector_type(16)));
typedef short bf16x8 __attribute__((ext_vector_type(8)));
typedef short bf16x4 __attribute__((ext_vector_type(4)));

constexpr int NB = 4, T = 8192, M = NB * T, D = 1024, DIN = 5640, NP = 5632, FF = 4096, PLE = 256;
constexpr float EPS = 1e-6f;
constexpr size_t MiB = 1u << 20;
constexpr size_t SEG = (size_t)M * 512;
constexpr size_t WS_CTL = 0;
constexpr size_t WS_BAR = 768 * 1024;
constexpr size_t WS_GB = 1 * MiB;
constexpr size_t WS_WIN = 2 * MiB, WS_WOA = 13 * MiB, WS_WOB = 14 * MiB, WS_WOUT = 15 * MiB, WS_WUP = 17 * MiB, WS_WDN = 25 * MiB, WS_WPG = 33 * MiB, WS_WPLE = 35 * MiB;
constexpr size_t WS_PBF = 36 * MiB;
constexpr size_t WS_XN = 52 * MiB;
constexpr size_t WS_SEG = 116 * MiB;
constexpr size_t WS_END = WS_SEG + 11 * 32 * MiB;
constexpr size_t DO_U = 0, DO_W = 32 * MiB, DO_A = 64 * MiB, DO_VT = 80 * MiB;

constexpr int LDS_MISC = 131072, LDS_BYTES = 131072 + 1024;
constexpr int NQ_GDN = 16, NQ_ATT = 1024;

__device__ __forceinline__ unsigned f2bf(float f) { unsigned u = __builtin_bit_cast(unsigned, f); return (u + 0x7fffu + ((u >> 16) & 1u)) >> 16; }
typedef float f32x2_t __attribute__((ext_vector_type(2))); typedef __bf16 bf16x2_t __attribute__((ext_vector_type(2)));
__device__ __forceinline__ unsigned pk2(float lo, float hi) { f32x2_t v = {lo, hi}; bf16x2_t b = __builtin_convertvector(v, bf16x2_t); return __builtin_bit_cast(unsigned, b); }
__device__ __forceinline__ float bf2f(unsigned short b) { return __uint_as_float((unsigned)b << 16); }
__device__ __forceinline__ float bflo(unsigned w) { return __uint_as_float(w << 16); }
__device__ __forceinline__ float bfhi(unsigned w) { return __uint_as_float(w & 0xffff0000u); }
__device__ __forceinline__ float wave_sum(float v);
__device__ __forceinline__ float silu(float x) { return x / (1.0f + __expf(-x)); }
__device__ __forceinline__ float dpp_xor1(float v) { return __builtin_bit_cast(float, __builtin_amdgcn_mov_dpp(__builtin_bit_cast(int, v), 0xB1, 0xF, 0xF, false)); }
__device__ __forceinline__ float dpp_xor2(float v) { return __builtin_bit_cast(float, __builtin_amdgcn_mov_dpp(__builtin_bit_cast(int, v), 0x4E, 0xF, 0xF, false)); }
__device__ __forceinline__ float dpp_hmirror(float v) { return __builtin_bit_cast(float, __builtin_amdgcn_mov_dpp(__builtin_bit_cast(int, v), 0x141, 0xF, 0xF, false)); }
__device__ __forceinline__ float dpp_ror4(float v) { return __builtin_bit_cast(float, __builtin_amdgcn_mov_dpp(__builtin_bit_cast(int, v), 0x124, 0xF, 0xF, false)); }
__device__ __forceinline__ float dpp_ror8(float v) { return __builtin_bit_cast(float, __builtin_amdgcn_mov_dpp(__builtin_bit_cast(int, v), 0x128, 0xF, 0xF, false)); }
__device__ __forceinline__ float dpp_rmirror(float v) { return __builtin_bit_cast(float, __builtin_amdgcn_mov_dpp(__builtin_bit_cast(int, v), 0x140, 0xF, 0xF, false)); }
__device__ __forceinline__ float wave_sum(float v) { v += dpp_xor1(v); v += dpp_xor2(v); v += dpp_ror4(v); v += dpp_ror8(v); v += __shfl_xor(v, 16); v += __shfl_xor(v, 32); return v; }
#define LDS_WAIT() asm volatile("s_waitcnt lgkmcnt(0)" ::: "memory")
#define LBAR() asm volatile("s_waitcnt lgkmcnt(0)\n\ts_barrier" ::: "memory")

struct Args {
    const float* x; const float* p; const int* pos; const float* attn_norm; const float* w_in; const float* conv_w; const float* a_log; const float* dt_bias; const float* gdn_norm;
    const float* w_o_a; const float* q_norm; const float* k_norm; const float* lq1; const float* lk1; const float* lq2; const float* lk2; const float* diff_norm; const float* w_o_b;
    const float* w_out; const float* mlp_norm; const float* w_up; const float* w_down; const float* ple_norm; const float* w_ple_gate; const float* w_ple;
    float* out; unsigned char* ws;
};

__device__ __forceinline__ void transpose_item(const float* W, int ldw, int K, bf16* WT, int n0_dst, int n0_src, int k0, const float* ks, LAS float* scr, int lane) {
    f32x4 ld[8];
#pragma unroll
    for (int i = 0; i < 8; ++i) { const int kk = 8 * i + (lane >> 3); ld[i] = *(const f32x4*)(W + (size_t)(k0 + kk) * ldw + n0_src + 4 * (lane & 7)); }
#pragma unroll
    for (int i = 0; i < 8; ++i) { const int kk = 8 * i + (lane >> 3); f32x4 v = ld[i]; if (ks) v = v * ks[k0 + kk];
        LAS float* d = scr + kk * 33 + 4 * (lane & 7); d[0] = v.x; d[1] = v.y; d[2] = v.z; d[3] = v.w; }
    LDS_WAIT(); asm volatile("" ::: "memory");
    const int c = lane & 7;
#pragma unroll
    for (int j = 0; j < 4; ++j) { const int n = (lane >> 3) + 8 * j; const LAS float* s = scr + (8 * c) * 33 + n;
        v4u o; o.x = pk2(s[0 * 33], s[1 * 33]); o.y = pk2(s[2 * 33], s[3 * 33]); o.z = pk2(s[4 * 33], s[5 * 33]); o.w = pk2(s[6 * 33], s[7 * 33]);
        *(v4u*)(WT + (size_t)(n0_dst + n) * K + k0 + 8 * c) = o; }
    LDS_WAIT(); asm volatile("" ::: "memory");
}
__device__ __forceinline__ void tr_matrix(int r, const float* W, int ldw, int K, int N, bf16* WT, const float* ks, bool win, LAS float* scr, int lane) {
    const int nblk = N / 32, kb = r / nblk, nb = r % nblk, n0 = 32 * nb; const int n0s = (win && n0 >= 2048) ? n0 + 8 : n0;
    transpose_item(W, ldw, K, WT, n0, n0s, 64 * kb, ks, scr, lane);
}
__device__ __forceinline__ void p0_prologue(const Args& A, unsigned char* lds_g) {
    LAS unsigned char* lds = (LAS unsigned char*)lds_g;
    int tid_ = threadIdx.x; asm volatile("" : "+v"(tid_)); const int tid = tid_, lane = tid & 63, wave = __builtin_amdgcn_readfirstlane(tid >> 6);
    unsigned char* ws = A.ws;
    LAS float* scr = (LAS float*)(lds + wave * 8448);
    LAS float* Wab = (LAS float*)(lds + 8 * 8448);
    for (int e = tid; e < 8192; e += 512) Wab[(e & 7) * 1024 + (e >> 3)] = A.w_in[(size_t)(e >> 3) * DIN + 2048 + (e & 7)];
    __syncthreads();
    const int gw = blockIdx.x * 8 + wave, NGW = gridDim.x * 8;
    constexpr int I1 = 16 * 176, I2 = 8 * 32, I3 = I2, I4 = 16 * 32, I5 = 16 * 128, I6 = 64 * 32, I7 = 16 * 32, I8 = 4 * 32;
    constexpr int NITEMS = I1 + I2 + I3 + I4 + I5 + I6 + I7 + I8;
    for (int it = gw; it < NITEMS; it += NGW) {
        int r = it;
        if (r < I1) { tr_matrix(r, A.w_in, DIN, D, NP, (bf16*)(ws + WS_WIN), nullptr, true, scr, lane); continue; } r -= I1;
        if (r < I2) { tr_matrix(r, A.w_o_a, D, 512, D, (bf16*)(ws + WS_WOA), nullptr, false, scr, lane); continue; } r -= I2;
        if (r < I3) { tr_matrix(r, A.w_o_b, D, 512, D, (bf16*)(ws + WS_WOB), nullptr, false, scr, lane); continue; } r -= I3;
        if (r < I4) { tr_matrix(r, A.w_out, D, D, D, (bf16*)(ws + WS_WOUT), nullptr, false, scr, lane); continue; } r -= I4;
        if (r < I5) { tr_matrix(r, A.w_up, FF, D, FF, (bf16*)(ws + WS_WUP), A.mlp_norm, false, scr, lane); continue; } r -= I5;
        if (r < I6) { tr_matrix(r, A.w_down, D, FF, D, (bf16*)(ws + WS_WDN), nullptr, false, scr, lane); continue; } r -= I6;
        if (r < I7) { tr_matrix(r, A.w_ple_gate, D, D, D, (bf16*)(ws + WS_WPG), A.ple_norm, false, scr, lane); continue; } r -= I7;
        tr_matrix(r, A.w_ple, D, PLE, D, (bf16*)(ws + WS_WPLE), nullptr, false, scr, lane);
    }
    bf16* XN = (bf16*)(ws + WS_XN); bf16* PB = (bf16*)(ws + WS_PBF);
    float* gbuf = (float*)(ws + WS_GB); float* bbuf = gbuf + (size_t)M * 4;
    f32x4 gn[4];
#pragma unroll
    for (int j = 0; j < 4; ++j) gn[j] = ((const f32x4*)A.attn_norm)[lane + 64 * j];
    f32x4 n1[4], n2[4], pn1, pn2;
    { const f32x4* xr = (const f32x4*)(A.x + (size_t)gw * D) + lane;
#pragma unroll
      for (int j = 0; j < 4; ++j) n1[j] = xr[64 * j];
      pn1 = ((const f32x4*)(A.p + (size_t)gw * PLE))[lane];
      const int m2 = (gw + NGW < M) ? gw + NGW : gw; const f32x4* xr2 = (const f32x4*)(A.x + (size_t)m2 * D) + lane;
#pragma unroll
      for (int j = 0; j < 4; ++j) n2[j] = xr2[64 * j];
      pn2 = ((const f32x4*)(A.p + (size_t)m2 * PLE))[lane]; }
    for (int m = gw; m < M; m += NGW) {
        {
        f32x4 vc[4]; const f32x4 pvc = pn1;
#pragma unroll
        for (int j = 0; j < 4; ++j) { vc[j] = n1[j]; n1[j] = n2[j]; }
        pn1 = pn2;
        { const int m3 = (m + 2 * NGW < M) ? m + 2 * NGW : m; const f32x4* xr3 = (const f32x4*)(A.x + (size_t)m3 * D) + lane;
#pragma unroll
          for (int j = 0; j < 4; ++j) n2[j] = xr3[64 * j];
          pn2 = ((const f32x4*)(A.p + (size_t)m3 * PLE))[lane]; }
        f32x4 v[4]; float s = 0.f;
#pragma unroll
        for (int j = 0; j < 4; ++j) { v[j] = vc[j]; s += (v[j].x * v[j].x + v[j].y * v[j].y) + (v[j].z * v[j].z + v[j].w * v[j].w); }
        const float rstd = rsqrtf(wave_sum(s) * (1.f / D) + EPS);
        float ab[8];
#pragma unroll
        for (int c = 0; c < 8; ++c) ab[c] = 0.f;
        unsigned long long* o8 = (unsigned long long*)(XN + (size_t)m * D) + lane;
#pragma unroll
        for (int j = 0; j < 4; ++j) { v[j] = v[j] * rstd * gn[j];
            o8[64 * j] = (unsigned long long)pk2(v[j].x, v[j].y) | ((unsigned long long)pk2(v[j].z, v[j].w) << 32);
#pragma unroll
            for (int c = 0; c < 8; ++c) { const f32x4 w4 = *(const LAS f32x4*)(Wab + c * 1024 + 256 * j + 4 * lane);
                ab[c] += (v[j].x * w4.x + v[j].y * w4.y) + (v[j].z * w4.z + v[j].w * w4.w); } }
        {
            const bool b0 = lane & 1, b1 = lane & 2, b2 = lane & 4;
            float w4[4], w2[2];
#pragma unroll
            for (int j = 0; j < 4; ++j) { const float send = b2 ? ab[j] : ab[j + 4], keep = b2 ? ab[j + 4] : ab[j]; w4[j] = keep + dpp_hmirror(send); }
#pragma unroll
            for (int j = 0; j < 2; ++j) { const float send = b1 ? w4[j] : w4[j + 2], keep = b1 ? w4[j + 2] : w4[j]; w2[j] = keep + dpp_xor2(send); }
            float tot; { const float send = b0 ? w2[0] : w2[1], keep = b0 ? w2[1] : w2[0]; tot = keep + dpp_xor1(send); }
            tot += dpp_ror8(tot); tot += __shfl_xor(tot, 16); tot += __shfl_xor(tot, 32);
            const float partner = dpp_ror4(tot);
            if (lane < 4) { const int hd = lane;
                const float xx = tot + A.dt_bias[hd]; const float sp = xx > 20.f ? xx : log1pf(expf(xx));
                gbuf[(size_t)m * 4 + hd] = -expf(A.a_log[hd]) * sp;
                bbuf[(size_t)m * 4 + hd] = 1.0f / (1.0f + expf(-partner));
            }
        }
        const f32x4 pv = pvc;
        ((unsigned long long*)(PB + (size_t)m * PLE))[lane] = (unsigned long long)pk2(pv.x, pv.y) | ((unsigned long long)pk2(pv.z, pv.w) << 32);
        }
    }
}

__device__ __forceinline__ f32x4 mfma16(bf16x8 a, bf16x8 b, f32x4 c) { return __builtin_amdgcn_mfma_f32_16x16x32_bf16(a, b, c, 0, 0, 0); }
__device__ __forceinline__ f32x16 mfma32(bf16x8 a, bf16x8 b, f32x16 c) { return __builtin_amdgcn_mfma_f32_32x32x16_bf16(a, b, c, 0, 0, 0); }

template <int I> struct SolveRow {
    static __device__ __forceinline__ void run(float (&Tc)[64], const LAS float* Lf, int vz, float lanef) {
        SolveRow<I - 1>::run(Tc, Lf, vz, lanef);
        float a0 = fmaxf(1.0f - fabsf(lanef - (float)I), 0.0f), a1 = 0.f;
#pragma unroll
        for (int jj = 0; jj < (I + 3) / 4; ++jj) {
            const f32x4 l4 = *(const LAS f32x4*)(Lf + vz + I * 68 + 4 * jj);
            if (4 * jj + 0 < I) a0 -= l4.x * Tc[4 * jj + 0];
            if (4 * jj + 1 < I) a1 -= l4.y * Tc[4 * jj + 1];
            if (4 * jj + 2 < I) a0 -= l4.z * Tc[4 * jj + 2];
            if (4 * jj + 3 < I) a1 -= l4.w * Tc[4 * jj + 3];
        }
        Tc[I] = a0 + a1;
    }
};
template <> struct SolveRow<-1> { static __device__ __forceinline__ void run(float (&)[64], const LAS float*, int, float) {} };

#define GDN_LOAD_RAW(RAW_, CW_, GB_, unit_) do { const int bh_ = (unit_) >> 7, n_ = (unit_) & 127, b_ = bh_ >> 2, h_ = bh_ & 3; const size_t mm0 = (size_t)b_ * T + (size_t)n_ * 64; \
        const int ch_ = threadIdx.x & 127, tl0_ = 16 * (threadIdx.x >> 7), tseq_ = n_ * 64 + tl0_; \
        _Pragma("unroll") for (int s_ = 0; s_ < 3; ++s_) { const bf16* src_ = (const bf16*)(A.ws + WS_SEG) + (size_t)s_ * SEG + h_ * 128 + ch_; \
            _Pragma("unroll") for (int i_ = 0; i_ < 19; ++i_) RAW_[s_][i_] = (tseq_ - 3 + i_ >= 0) ? src_[(mm0 + tl0_ + i_ - 3) * 512] : (bf16)0; \
            _Pragma("unroll") for (int j_ = 0; j_ < 4; ++j_) CW_[s_][j_] = A.conv_w[j_ * 1536 + s_ * 512 + h_ * 128 + ch_]; } \
        GB_[0] = ((const float*)(A.ws + WS_GB))[(mm0 + (threadIdx.x & 63)) * 4 + h_]; GB_[1] = ((const float*)(A.ws + WS_GB) + (size_t)M * 4)[(mm0 + (threadIdx.x & 63)) * 4 + h_]; } while (0)
__device__ __forceinline__ void gdn_pre_unit(const Args& A, unsigned char* lds_g, int unit, bf16 (&raw)[3][19], float (&cw)[3][4], float (&gb)[2], int unit_next) {
    LAS unsigned char* lds = (LAS unsigned char*)lds_g;
    int tid_ = threadIdx.x; asm volatile("" : "+v"(tid_)); const int tid = tid_, lane = tid & 63, wave = __builtin_amdgcn_readfirstlane(tid >> 6);
    unsigned char* ws = A.ws;
    const int bh = unit >> 7, n = unit & 127, b = bh >> 2, h = bh & 3;
    const size_t m0 = (size_t)b * T + (size_t)n * 64;
    LAS bf16* Qb = (LAS bf16*)(lds);
    LAS bf16* Kb = (LAS bf16*)(lds + 17408);
    LAS bf16* VbT = (LAS bf16*)(lds + 34816);
    LAS bf16* KgT = (LAS bf16*)(lds + 53248);
    LAS float* Lf = (LAS float*)(lds + 71680);
    LAS bf16* Tb = (LAS bf16*)(lds + 89088);
    LAS float* Gs = (LAS float*)(lds + 98304);
    LAS float* Bs = Gs + 64; LAS float* SSQ = Gs + 128; LAS float* SSK = Gs + 192;
    const float* gbuf = (const float*)(ws + WS_GB); const float* bbuf = gbuf + (size_t)M * 4;
    const bf16* SG = (const bf16*)(ws + WS_SEG);
    bf16* qd = (bf16*)(ws + WS_XN) + (size_t)unit * 8192; bf16* kdT = (bf16*)(ws + WS_XN + 32 * MiB) + (size_t)unit * 8192;
    bf16* ub = (bf16*)((unsigned char*)A.out + DO_U) + (size_t)unit * 8192; bf16* wb = (bf16*)((unsigned char*)A.out + DO_W) + (size_t)unit * 8192;
    bf16* ab = (bf16*)((unsigned char*)A.out + DO_A) + (size_t)unit * 4096;
    float* egl = (float*)(ws + WS_CTL + 524288);
    if (wave == 0) {
        float gv = gb[0];
#pragma unroll
        for (int o = 1; o < 64; o <<= 1) { const float y = __shfl_up(gv, o); if (lane >= o) gv += y; }
        Gs[lane] = gv; Bs[lane] = gb[1]; SSQ[lane] = 0.f; SSK[lane] = 0.f;
        if (lane == 63) egl[(size_t)unit * 32] = __expf(gv);
    }
    LBAR();
    const int ch = tid & 127, tg = tid >> 7;
    float y[3][16];
#pragma unroll
    for (int s = 0; s < 3; ++s) {
        const int cidx = s * 512 + h * 128 + ch;
        const float w0 = cw[s][0], w1 = cw[s][1], w2 = cw[s][2], w3 = cw[s][3];
        float a0 = bf2f(raw[s][0]), a1 = bf2f(raw[s][1]), a2 = bf2f(raw[s][2]);
#pragma unroll
        for (int i = 0; i < 16; ++i) { const float a3 = bf2f(raw[s][3 + i]); y[s][i] = silu(w0 * a0 + w1 * a1 + w2 * a2 + w3 * a3); a0 = a1; a1 = a2; a2 = a3; }
    }
    if (unit_next < 2048) GDN_LOAD_RAW(raw, cw, gb, unit_next);
    {
        const bool b0 = lane & 1, b1 = lane & 2, b2 = lane & 4, b3 = lane & 8;
        float tot[2];
#pragma unroll
        for (int st = 0; st < 2; ++st) {
            float w8[8], w4[4], w2[2];
#pragma unroll
            for (int j = 0; j < 8; ++j) { const float lo = y[st][j] * y[st][j], hi = y[st][j + 8] * y[st][j + 8]; const float send = b3 ? lo : hi, keep = b3 ? hi : lo; w8[j] = keep + dpp_rmirror(send); }
#pragma unroll
            for (int j = 0; j < 4; ++j) { const float send = b2 ? w8[j] : w8[j + 4], keep = b2 ? w8[j + 4] : w8[j]; w4[j] = keep + dpp_hmirror(send); }
#pragma unroll
            for (int j = 0; j < 2; ++j) { const float send = b1 ? w4[j] : w4[j + 2], keep = b1 ? w4[j + 2] : w4[j]; w2[j] = keep + dpp_xor2(send); }
            { const float send = b0 ? w2[0] : w2[1], keep = b0 ? w2[1] : w2[0]; tot[st] = keep + dpp_xor1(send); }
            tot[st] += __shfl_xor(tot[st], 16); tot[st] += __shfl_xor(tot[st], 32);
        }
        const int tok = lane & 15;
        if (lane < 16) { atomicAdd((float*)(SSQ + 16 * tg + tok), tot[0]); atomicAdd((float*)(SSK + 16 * tg + tok), tot[1]); }
    }
    LBAR();
    {
        const float g63 = Gs[63];
        unsigned vq[8], vk[8], vv[8], vd[8];
#pragma unroll
        for (int i = 0; i < 16; ++i) { const int tl = 16 * tg + i; const float rq = rsqrtf(SSQ[tl] + EPS), rk = rsqrtf(SSK[tl] + EPS), G = Gs[tl], be = Bs[tl], eG = __expf(G);
            const float qn = y[0][i] * rq, kn = y[1][i] * rk;
            Qb[tl * 136 + ch] = (bf16)f2bf(qn); Kb[tl * 136 + ch] = (bf16)f2bf(kn);
            const unsigned kg = f2bf(kn * be * eG), vb = f2bf(y[2][i] * be), kdv = f2bf(kn * __expf(g63 - G));
            if (i & 1) { vk[i >> 1] |= kg << 16; vv[i >> 1] |= vb << 16; vd[i >> 1] |= kdv << 16; } else { vk[i >> 1] = kg; vv[i >> 1] = vb; vd[i >> 1] = kdv; }
        }
        (void)vq;
        *(LAS v4u*)(KgT + ch * 72 + 16 * tg) = (v4u){vk[0], vk[1], vk[2], vk[3]}; *(LAS v4u*)(KgT + ch * 72 + 16 * tg + 8) = (v4u){vk[4], vk[5], vk[6], vk[7]};
        *(LAS v4u*)(VbT + ch * 72 + 16 * tg) = (v4u){vv[0], vv[1], vv[2], vv[3]}; *(LAS v4u*)(VbT + ch * 72 + 16 * tg + 8) = (v4u){vv[4], vv[5], vv[6], vv[7]};
        { const int blk = ch >> 4, rr_ = ch & 15, ks_ = tg >> 1, g0 = (2 * tg) & 3;
          *(v4u*)(kdT + (((blk * 2 + ks_) * 64 + g0 * 16 + rr_) << 3)) = (v4u){vd[0], vd[1], vd[2], vd[3]};
          *(v4u*)(kdT + (((blk * 2 + ks_) * 64 + (g0 + 1) * 16 + rr_) << 3)) = (v4u){vd[4], vd[5], vd[6], vd[7]}; }
    }
    LBAR();
    const int r = lane & 15, g = lane >> 4;
    {
#pragma unroll
        for (int pp = 0; pp < 2; ++pp) { const int p = tid + 512 * pp, frb = p >> 8, fks = (p >> 6) & 3, fl = p & 63, trow = 16 * frb + (fl & 15);
            const v4u qv = *(const LAS v4u*)(Qb + trow * 136 + 32 * fks + 8 * (fl >> 4)); const float sc = 0.08838834764831845f * __expf(Gs[trow]);
            v4u o; o.x = pk2(bflo(qv.x) * sc, bfhi(qv.x) * sc); o.y = pk2(bflo(qv.y) * sc, bfhi(qv.y) * sc); o.z = pk2(bflo(qv.z) * sc, bfhi(qv.z) * sc); o.w = pk2(bflo(qv.w) * sc, bfhi(qv.w) * sc);
            *(v4u*)(qd + ((size_t)p << 3)) = o; }
    }
    LAS bf16* Abuf = (LAS bf16*)(lds + 99328);
    {
        const int rb = wave & 3, which = wave >> 2;
        const LAS bf16* srcA = which ? Qb : Kb;
        bf16x8 af[4];
#pragma unroll
        for (int ks = 0; ks < 4; ++ks) af[ks] = *(const LAS bf16x8*)(srcA + (16 * rb + r) * 136 + 32 * ks + 8 * g);
#pragma unroll
        for (int cb = 0; cb < 4; ++cb) { f32x4 acc = {0.f, 0.f, 0.f, 0.f};
#pragma unroll
            for (int ks = 0; ks < 4; ++ks) { const bf16x8 bfr = *(const LAS bf16x8*)(Kb + (16 * cb + r) * 136 + 32 * ks + 8 * g); acc = mfma16(af[ks], bfr, acc); }
            const int s = 16 * cb + r; const float Gsv = Gs[s];
#pragma unroll
            for (int i = 0; i < 4; ++i) { const int c = 16 * rb + 4 * g + i; const float Gc = Gs[c];
                if (which == 0) { const float val = (s < c) ? Bs[c] * acc[i] * __expf(Gc - Gsv) : 0.f; Lf[c * 68 + s] = val; }
                else { const float val = (s <= c) ? 0.08838834764831845f * acc[i] * __expf(Gc - Gsv) : 0.f; Abuf[c * 72 + s] = (bf16)f2bf(val); } }
        }
    }
    LBAR();
    if (wave >= 4) {
#pragma unroll
        for (int pp = 0; pp < 2; ++pp) { const int p = (tid - 256) + 256 * pp, frb = p >> 7, fks = (p >> 6) & 1, fl = p & 63;
            *(v4u*)(ab + ((size_t)p << 3)) = *(const LAS v4u*)(Abuf + (16 * frb + (fl & 15)) * 72 + 32 * fks + 8 * (fl >> 4)); }
    }
    if (wave == 0) {
        float Tc[64]; int vz = 0; asm volatile("" : "+v"(vz));
        SolveRow<63>::run(Tc, Lf, vz, (float)lane);
#pragma unroll
        for (int i = 0; i < 64; ++i) Tb[i * 72 + lane] = (bf16)f2bf(Tc[i]);
    }
    LBAR();
    {
        const int rb = wave & 3, which = wave >> 2;
        const LAS bf16* srcB = which ? KgT : VbT; bf16* dst = which ? wb : ub;
        bf16x8 af[2];
#pragma unroll
        for (int ks = 0; ks < 2; ++ks) af[ks] = *(const LAS bf16x8*)(Tb + (16 * rb + r) * 72 + 32 * ks + 8 * g);
#pragma unroll
        for (int cb = 0; cb < 8; ++cb) { f32x4 acc = {0.f, 0.f, 0.f, 0.f};
#pragma unroll
            for (int ks = 0; ks < 2; ++ks) { const bf16x8 bfr = *(const LAS bf16x8*)(srcB + (16 * cb + r) * 72 + 32 * ks + 8 * g); acc = mfma16(af[ks], bfr, acc); }
            if (which == 0) { *(v2u*)(dst + (((rb * 8 + cb) * 64 + lane) << 2)) = (v2u){pk2(acc[0], acc[1]), pk2(acc[2], acc[3])}; }
            else {
#pragma unroll
            for (int i = 0; i < 4; ++i) { const int c_ = 16 * rb + 4 * g + i, k_ = 16 * cb + r;
                Qb[c_ * 136 + k_] = (bf16)f2bf(acc[i]); } }
        }
    }
    LBAR();
    {
#pragma unroll
        for (int pp = 0; pp < 2; ++pp) { const int p = tid + 512 * pp, frb = p >> 8, fks = (p >> 6) & 3, fl = p & 63;
            *(v4u*)(wb + ((size_t)p << 3)) = *(const LAS v4u*)(Qb + (16 * frb + (fl & 15)) * 136 + 32 * fks + 8 * (fl >> 4)); }
    }
    LBAR();
}

__device__ __forceinline__ void diff_prep_unit(const Args& A, unsigned char* lds_g, int mt) {
    LAS unsigned char* lds = (LAS unsigned char*)lds_g;
    int tid_ = threadIdx.x; asm volatile("" : "+v"(tid_)); const int tid = tid_, lane = tid & 63, wave = __builtin_amdgcn_readfirstlane(tid >> 6);
    unsigned char* ws = A.ws;
    bf16* SG = (bf16*)(ws + WS_SEG);
    const size_t m0 = (size_t)mt * 64;
    const float invf[8] = {1.0f, 0.1939227432012558f, 0.03760603070259094f, 0.007292664609849453f, 0.0014142135623842478f, 0.00027424818836152554f, 5.3182957344688475e-05f, 1.0313385246263351e-05f};
    const int dl = (lane & 7) * 8;
    float gq[8], gk[8];
#pragma unroll
    for (int e = 0; e < 8; ++e) { gq[e] = A.q_norm[dl + e]; gk[e] = A.k_norm[dl + e]; }
    v4u rawv[8][2]; int posv[8];
#pragma unroll
    for (int rr = 0; rr < 8; ++rr) { const size_t m = m0 + wave * 8 + rr; posv[rr] = A.pos[m];
        rawv[rr][0] = *(const v4u*)(SG + (size_t)4 * SEG + m * 512 + 8 * lane); rawv[rr][1] = *(const v4u*)(SG + (size_t)5 * SEG + m * 512 + 8 * lane); }
#pragma unroll
    for (int rr = 0; rr < 8; ++rr) {
        const size_t m = m0 + wave * 8 + rr;
        const float posf = (float)posv[rr];
        float cs[8], sn[8];
        {
            const int e8 = lane & 7;
            const float invl = e8 == 0 ? invf[0] : e8 == 1 ? invf[1] : e8 == 2 ? invf[2] : e8 == 3 ? invf[3] : e8 == 4 ? invf[4] : e8 == 5 ? invf[5] : e8 == 6 ? invf[6] : invf[7];
            const float ang = posf * invl; const double ad = (double)ang; const double nn = __builtin_rint(ad * 0.15915494309189535); const float rr2 = (float)(ad - nn * 6.283185307179586);
            const float c1 = __cosf(rr2), s1 = __sinf(rr2);
#pragma unroll
            for (int e = 0; e < 8; ++e) { cs[e] = __shfl(c1, (lane & ~7) | e); sn[e] = __shfl(s1, (lane & ~7) | e); }
        }
#pragma unroll
        for (int arr = 0; arr < 2; ++arr) {
            bf16* ptr = SG + (size_t)(4 + arr) * SEG + m * 512 + 8 * lane;
            const v4u raw = rawv[rr][arr];
            float v[8] = {bflo(raw.x), bfhi(raw.x), bflo(raw.y), bfhi(raw.y), bflo(raw.z), bfhi(raw.z), bflo(raw.w), bfhi(raw.w)};
            float ss = 0.f;
#pragma unroll
            for (int e = 0; e < 8; ++e) ss += v[e] * v[e];
            ss += dpp_xor1(ss); ss += dpp_xor2(ss); ss += dpp_hmirror(ss);
            const float rstd = rsqrtf(ss * (1.0f / 64.0f) + EPS);
#pragma unroll
            for (int e = 0; e < 8; ++e) v[e] = v[e] * rstd * (arr ? gk[e] : gq[e]);
            const int l7 = lane & 7;
#pragma unroll
            for (int e = 0; e < 8; ++e) { const float other = dpp_xor1(v[e]);
                if (l7 == 0) v[e] = v[e] * cs[e] - other * sn[e]; else if (l7 == 1) v[e] = v[e] * cs[e] + other * sn[e]; }
            const float sc = arr ? 1.0f : 0.125f * 1.4426950408889634f;
            v4u o; o.x = pk2(v[0] * sc, v[1] * sc); o.y = pk2(v[2] * sc, v[3] * sc); o.z = pk2(v[4] * sc, v[5] * sc); o.w = pk2(v[6] * sc, v[7] * sc);
            *(v4u*)ptr = o;
        }
    }
    LAS bf16* tile = (LAS bf16*)lds;
    const bf16* vsrc = SG + (size_t)6 * SEG + m0 * 512;
#pragma unroll
    for (int i = 0; i < 8; ++i) { const int id = tid + 512 * i, row = id >> 6, c16 = id & 63; *(LAS v4u*)(tile + row * 520 + c16 * 8) = *(const v4u*)(vsrc + (size_t)row * 512 + c16 * 8); }
    __syncthreads();
    {
        const int b = (int)(m0 / T), tt = (int)((m0 % T) / 64), hh = tid >> 7, d = tid & 127;
        bf16* dst = (bf16*)((unsigned char*)A.out + DO_VT) + (((size_t)(b * 4 + hh) * 128 + tt) * 128 + d) * 64;
#pragma unroll
        for (int c8 = 0; c8 < 8; ++c8) { unsigned w[4];
#pragma unroll
            for (int e = 0; e < 4; ++e) { const int q2 = 2 * e, kv = 16 * (c8 >> 1) + 8 * (q2 >> 2) + 4 * (c8 & 1) + (q2 & 3);
                const unsigned lo = tile[kv * 520 + tid], hi = tile[(kv + 1) * 520 + tid]; w[e] = lo | (hi << 16); }
            *(v4u*)(dst + c8 * 8) = (v4u){w[0], w[1], w[2], w[3]}; }
    }
    __syncthreads();
}

__device__ __forceinline__ void gdn_scan_item(const Args& A, unsigned char* lds_g, int bh) {
    LAS unsigned char* lds = (LAS unsigned char*)lds_g;
    int tid_ = threadIdx.x; asm volatile("" : "+v"(tid_)); const int tid = tid_, lane = tid & 63, wave = __builtin_amdgcn_readfirstlane(tid >> 6);
    unsigned char* ws = A.ws;
    const int r = lane & 15, g = lane >> 4, sl = wave, b = bh >> 2, h = bh & 3;
    LAS bf16* H1 = (LAS bf16*)lds;
    LAS bf16* H2 = (LAS bf16*)(lds + 32768);
    LAS bf16* ST = (LAS bf16*)(lds + 57344) + wave * 3328;
    LAS bf16* VN = ST + 2176;
    const v4u* qd4 = (const v4u*)((const bf16*)(ws + WS_XN) + (size_t)bh * 128 * 8192); const v4u* kd4 = (const v4u*)((const bf16*)(ws + WS_XN + 32 * MiB) + (size_t)bh * 128 * 8192);
    const v4u* wb4 = (const v4u*)((const bf16*)((unsigned char*)A.out + DO_W) + (size_t)bh * 128 * 8192); const v4u* ab4 = (const v4u*)((const bf16*)((unsigned char*)A.out + DO_A) + (size_t)bh * 128 * 4096);
    const bf16* ub = (const bf16*)((unsigned char*)A.out + DO_U) + (size_t)bh * 128 * 8192;
    const float* egl = (const float*)(ws + WS_CTL + 524288) + (size_t)bh * 128 * 32;
    float* oraw = (float*)(ws + WS_SEG) + ((size_t)b * T) * 512 + h * 128 + 16 * sl + r;
    f32x4 S[8];
#pragma unroll
    for (int k = 0; k < 8; ++k) { S[k] = (f32x4){0.f, 0.f, 0.f, 0.f}; *(LAS v2u*)(ST + r * 136 + 16 * k + 4 * g) = (v2u){0u, 0u}; }
    v4u sA[7], sB[7];
#define SCAN_LOADOPS(S_, i_) do { const size_t o1 = (size_t)(i_) * 1024, o2 = (size_t)(i_) * 512; \
        S_[0] = wb4[o1 + tid]; S_[1] = wb4[o1 + tid + 512]; S_[2] = qd4[o1 + tid]; S_[3] = qd4[o1 + tid + 512]; \
        S_[4] = ab4[o2 + tid]; S_[5] = kd4[o1 + tid]; S_[6] = kd4[o1 + tid + 512]; } while (0)
#define SCAN_WRITE_H1(S_) do { LAS v4u* p_ = (LAS v4u*)H1; p_[tid] = S_[0]; p_[tid + 512] = S_[1]; p_[1024 + tid] = S_[2]; p_[1536 + tid] = S_[3]; } while (0)
#define SCAN_WRITE_H2(S_) do { LAS v4u* p_ = (LAS v4u*)H2; p_[tid] = S_[4]; p_[512 + tid] = S_[5]; p_[1024 + tid] = S_[6]; } while (0)
    SCAN_LOADOPS(sA, 0); SCAN_WRITE_H1(sA); SCAN_WRITE_H2(sA);
    SCAN_LOADOPS(sB, 1);
    v2u uC[4], uN[4]; float eg = egl[0], egN = eg;
#pragma unroll
    for (int rb = 0; rb < 4; ++rb) uC[rb] = *(const v2u*)(ub + (((rb * 8 + sl) * 64 + lane) << 2));
    __syncthreads();
#define SCAN_STEP(i_, SNEXT_, SLOAD_) do { \
        if ((i_) + 2 < 128) SCAN_LOADOPS(SLOAD_, (i_) + 2); \
        { const int in_ = ((i_) + 1 < 128) ? (i_) + 1 : 127; \
          _Pragma("unroll") for (int rb = 0; rb < 4; ++rb) uN[rb] = *(const v2u*)(ub + (size_t)in_ * 8192 + (((rb * 8 + sl) * 64 + lane) << 2)); \
          egN = egl[(size_t)in_ * 32]; } \
        bf16x8 sb[4]; \
        _Pragma("unroll") for (int ks = 0; ks < 4; ++ks) sb[ks] = *(const LAS bf16x8*)(ST + r * 136 + 32 * ks + 8 * g); \
        f32x4 acc2[4]; \
        _Pragma("unroll") for (int rb = 0; rb < 4; ++rb) { \
            f32x4 acc1 = {0.f, 0.f, 0.f, 0.f}; acc2[rb] = (f32x4){0.f, 0.f, 0.f, 0.f}; \
            _Pragma("unroll") for (int ks = 0; ks < 4; ++ks) { \
                const bf16x8 wf = *(const LAS bf16x8*)(H1 + (((rb * 4 + ks) * 64 + lane) << 3)), qf = *(const LAS bf16x8*)(H1 + 8192 + (((rb * 4 + ks) * 64 + lane) << 3)); \
                acc1 = mfma16(wf, sb[ks], acc1); acc2[rb] = mfma16(qf, sb[ks], acc2[rb]); } \
            const float v0 = bflo(uC[rb].x) - acc1[0], v1 = bfhi(uC[rb].x) - acc1[1], v2 = bflo(uC[rb].y) - acc1[2], v3 = bfhi(uC[rb].y) - acc1[3]; \
            *(LAS v2u*)(VN + r * 72 + 16 * rb + 4 * g) = (v2u){pk2(v0, v1), pk2(v2, v3)}; } \
        LBAR(); \
        if ((i_) + 1 < 128) SCAN_WRITE_H1(SNEXT_); \
        bf16x8 vb[2]; \
        _Pragma("unroll") for (int ks = 0; ks < 2; ++ks) vb[ks] = *(const LAS bf16x8*)(VN + r * 72 + 32 * ks + 8 * g); \
        _Pragma("unroll") for (int rb = 0; rb < 4; ++rb) { \
            _Pragma("unroll") for (int ks = 0; ks < 2; ++ks) { const bf16x8 af = *(const LAS bf16x8*)(H2 + (((rb * 2 + ks) * 64 + lane) << 3)); acc2[rb] = mfma16(af, vb[ks], acc2[rb]); } \
            float* op = oraw + ((size_t)(i_) * 64 + 16 * rb + 4 * g) * 512; \
            op[0] = acc2[rb][0]; op[512] = acc2[rb][1]; op[1024] = acc2[rb][2]; op[1536] = acc2[rb][3]; } \
        _Pragma("unroll") for (int k = 0; k < 8; ++k) { S[k] = S[k] * eg; \
            _Pragma("unroll") for (int ks = 0; ks < 2; ++ks) { const bf16x8 kf = *(const LAS bf16x8*)(H2 + 4096 + (((k * 2 + ks) * 64 + lane) << 3)); S[k] = mfma16(kf, vb[ks], S[k]); } \
            *(LAS v2u*)(ST + r * 136 + 16 * k + 4 * g) = (v2u){pk2(S[k][0], S[k][1]), pk2(S[k][2], S[k][3])}; } \
        LBAR(); \
        if ((i_) + 1 < 128) SCAN_WRITE_H2(SNEXT_); \
        _Pragma("unroll") for (int rb = 0; rb < 4; ++rb) uC[rb] = uN[rb]; \
        eg = egN; \
    } while (0)
    for (int i = 0; i < 128; i += 2) { SCAN_STEP(i, sB, sA); SCAN_STEP(i + 1, sA, sB); }
    __syncthreads();
#undef SCAN_STEP
#undef SCAN_LOADOPS
#undef SCAN_WRITE_H1
#undef SCAN_WRITE_H2
}

__device__ __forceinline__ void attn_unit(const Args& A, unsigned char* lds_g, int bh, int qb, float negshift, float lam) {
    LAS unsigned char* lds = (LAS unsigned char*)lds_g;
    int tid_ = threadIdx.x; asm volatile("" : "+v"(tid_)); const int tid = tid_, lane = tid & 63, wave = __builtin_amdgcn_readfirstlane(tid >> 6);
    unsigned char* ws = A.ws;
    const int r = lane & 31, hh = lane >> 5, comp = wave >> 2, w4 = wave & 3;
    const int b = bh >> 2, h = bh & 3;
    const size_t rowbase = (size_t)b * T; const int q0 = qb * 128;
    const bf16* DQ = (const bf16*)(ws + WS_SEG) + (size_t)4 * SEG; const bf16* DK = (const bf16*)(ws + WS_SEG) + (size_t)5 * SEG;
    const bf16* VT = (const bf16*)((unsigned char*)A.out + DO_VT) + (size_t)bh * 128 * 8192;
    bf16* OB = (bf16*)(ws + WS_SEG) + (size_t)6 * SEG;
    LAS bf16* Ks = (LAS bf16*)lds;
    LAS bf16* Vs = (LAS bf16*)(lds + 34816);
    LAS bf16* Qs = (LAS bf16*)(lds + 90112);
#pragma unroll
    for (int i = 0; i < 4; ++i) { const int id = tid + 512 * i, qrow = id >> 4, qch = id & 15;
        *(LAS v4u*)(Qs + qrow * 136 + qch * 8) = *(const v4u*)(DQ + (rowbase + q0 + qrow) * 512 + h * 128 + qch * 8); }
    const LAS bf16* qfp = Qs + (32 * w4 + r) * 136 + comp * 64 + 8 * hh;
    f32x16 o[4];
#pragma unroll
    for (int d = 0; d < 4; ++d)
#pragma unroll
        for (int i = 0; i < 16; ++i) o[d][i] = 0.f;
    float lsum = 0.f;
    const int nt = 2 * (qb + 1);
    const int id0 = tid, id1 = tid + 512;
    const bf16* ksrc0 = DK + (rowbase + (id0 >> 4)) * 512 + h * 128 + (id0 & 15) * 8; const bf16* ksrc1 = DK + (rowbase + (id1 >> 4)) * 512 + h * 128 + (id1 & 15) * 8;
    const int kdst0 = (id0 >> 4) * 136 + (id0 & 15) * 8, kdst1 = (id1 >> 4) * 136 + (id1 & 15) * 8;
    const int vdst0 = (id0 >> 3) * 72 + (id0 & 7) * 8, vdst1 = (id1 >> 3) * 72 + (id1 & 7) * 8;
    v4u kr0, kr1, vr0, vr1;
#define ATT_LOADK(S_, t_) do { kr0 = *(const v4u*)(ksrc0 + (size_t)(t_) * 64 * 512); kr1 = *(const v4u*)(ksrc1 + (size_t)(t_) * 64 * 512); } while (0)
#define ATT_LOADV(t_) do { vr0 = *(const v4u*)(VT + (size_t)(t_) * 8192 + id0 * 8); vr1 = *(const v4u*)(VT + (size_t)(t_) * 8192 + id1 * 8); } while (0)
#define ATT_WRITE(S_, kbuf_, voff_) do { LAS bf16* kb_ = Ks + (kbuf_) * (64 * 136); LAS bf16* vb_ = Vs + (voff_); \
        *(LAS v4u*)(kb_ + kdst0) = kr0; *(LAS v4u*)(kb_ + kdst1) = kr1; \
        *(LAS v4u*)(vb_ + vdst0) = vr0; *(LAS v4u*)(vb_ + vdst1) = vr1; } while (0)
    ATT_LOADK(A, 0); ATT_LOADV(0); ATT_WRITE(A, 0, 0);
    __syncthreads();
    const int qrel = 32 * w4 + r;
    constexpr int VSZ = 128 * 72;
    int vcur = 0, vprev = 2 * VSZ, vnext = VSZ;
    bf16x8 pbp[2][2];
#pragma unroll
    for (int a = 0; a < 2; ++a)
#pragma unroll
        for (int b2 = 0; b2 < 2; ++b2) pbp[a][b2] = (bf16x8){0, 0, 0, 0, 0, 0, 0, 0};
    for (int e = tid; e < VSZ / 8; e += 512) *(LAS v4u*)(Vs + 2 * VSZ + e * 8) = (v4u){0u, 0u, 0u, 0u};
    __syncthreads();
#define ATT_VFRAGP(d_, kb_, s_) (*(const LAS bf16x8*)(Vp + (32 * (d_) + r) * 72 + 32 * (kb_) + 16 * (s_) + 8 * hh))
#define ATT_EXP8(P_, S2_, KB_, BANDED, DST_) do { \
        _Pragma("unroll") for (int i = 8 * (S2_); i < 8 * (S2_) + 8; ++i) { float e = __builtin_amdgcn_exp2f(P_[i]); \
            if (BANDED) { const int kvrel = 64 * band + 32 * (KB_) + (i & 3) + 8 * (i >> 2) + 4 * hh; if (kvrel > qrel) e = 0.f; } \
            P_[i] = e; lsum += e; } \
        { v4u w; w.x = pk2(P_[8 * (S2_) + 0], P_[8 * (S2_) + 1]); w.y = pk2(P_[8 * (S2_) + 2], P_[8 * (S2_) + 3]); \
            w.z = pk2(P_[8 * (S2_) + 4], P_[8 * (S2_) + 5]); w.w = pk2(P_[8 * (S2_) + 6], P_[8 * (S2_) + 7]); DST_ = __builtin_bit_cast(bf16x8, w); } \
    } while (0)
#define ATT_TILE(BANDED, PAR_, LOADS_, WRITES_) do { \
        LOADS_; \
        const LAS bf16* Kb = Ks + (PAR_) * (64 * 136); const LAS bf16* Vp = Vs + vprev; \
        const int band = t - (nt - 2); \
        bf16x8 kf[2][4], qf[4]; \
        _Pragma("unroll") for (int kb = 0; kb < 2; ++kb) _Pragma("unroll") for (int ks = 0; ks < 4; ++ks) kf[kb][ks] = *(const LAS bf16x8*)(Kb + (32 * kb + r) * 136 + comp * 64 + 16 * ks + 8 * hh); \
        _Pragma("unroll") for (int ks = 0; ks < 4; ++ks) qf[ks] = *(const LAS bf16x8*)(qfp + 16 * ks); \
        __builtin_amdgcn_sched_barrier(0); \
        f32x16 p0, p1; \
        _Pragma("unroll") for (int i = 0; i < 16; ++i) { p0[i] = negshift; p1[i] = negshift; } \
        _Pragma("unroll") for (int ks = 0; ks < 4; ++ks) p0 = mfma32(kf[0][ks], qf[ks], p0); \
        _Pragma("unroll") for (int ks = 0; ks < 4; ++ks) p1 = mfma32(kf[1][ks], qf[ks], p1); \
        bf16x8 vfa[8]; \
        _Pragma("unroll") for (int d = 0; d < 4; ++d) _Pragma("unroll") for (int s2 = 0; s2 < 2; ++s2) vfa[d * 2 + s2] = ATT_VFRAGP(d, 0, s2); \
        __builtin_amdgcn_sched_barrier(0); \
        bf16x8 pbn[2][2]; \
          \
        _Pragma("unroll") for (int d = 0; d < 4; ++d) o[d] = mfma32(vfa[d * 2 + 0], pbp[0][0], o[d]); \
        ATT_EXP8(p0, 0, 0, BANDED, pbn[0][0]); \
        _Pragma("unroll") for (int d = 0; d < 4; ++d) o[d] = mfma32(vfa[d * 2 + 1], pbp[0][1], o[d]); \
        ATT_EXP8(p0, 1, 0, BANDED, pbn[0][1]); \
        bf16x8 vfb[8]; \
        _Pragma("unroll") for (int d = 0; d < 4; ++d) _Pragma("unroll") for (int s2 = 0; s2 < 2; ++s2) vfb[d * 2 + s2] = ATT_VFRAGP(d, 1, s2); \
        __builtin_amdgcn_sched_barrier(0); \
        _Pragma("unroll") for (int d = 0; d < 4; ++d) o[d] = mfma32(vfb[d * 2 + 0], pbp[1][0], o[d]); \
        ATT_EXP8(p1, 0, 1, BANDED, pbn[1][0]); \
        _Pragma("unroll") for (int d = 0; d < 4; ++d) o[d] = mfma32(vfb[d * 2 + 1], pbp[1][1], o[d]); \
        ATT_EXP8(p1, 1, 1, BANDED, pbn[1][1]); \
        __builtin_amdgcn_sched_barrier(0); \
        _Pragma("unroll") for (int a = 0; a < 2; ++a) _Pragma("unroll") for (int b2 = 0; b2 < 2; ++b2) pbp[a][b2] = pbn[a][b2]; \
        WRITES_; \
        { const int tmp = vprev; vprev = vcur; vcur = vnext; vnext = tmp; } \
        __syncthreads(); \
    } while (0)
    int t = 0;
    for (; t < nt - 2; t += 2) {
        ATT_TILE(false, 0, { ATT_LOADK(A, t + 1); ATT_LOADV(t + 1); }, ATT_WRITE(B, 1, vnext));
        ++t; ATT_TILE(false, 1, { ATT_LOADK(B, t + 1); ATT_LOADV(t + 1); }, ATT_WRITE(A, 0, vnext)); --t;
    }
    ATT_TILE(true, 0, { ATT_LOADK(A, t + 1); ATT_LOADV(t + 1); }, ATT_WRITE(B, 1, vnext)); ++t;
    ATT_TILE(true, 1, (void)0, (void)0);
    {
        const LAS bf16* Vp = Vs + vprev;
#pragma unroll
        for (int kb = 0; kb < 2; ++kb)
#pragma unroll
            for (int s2 = 0; s2 < 2; ++s2)
#pragma unroll
                for (int d = 0; d < 4; ++d) o[d] = mfma32(ATT_VFRAGP(d, kb, s2), pbp[kb][s2], o[d]);
    }
    __syncthreads();
#undef ATT_TILE
#undef ATT_EXP8
#undef ATT_VFRAGP
#undef ATT_LOADK
#undef ATT_LOADV
#undef ATT_WRITE
    lsum += __shfl_xor(lsum, 32);
    const float inv = 1.0f / lsum;
    LAS float* X = (LAS float*)lds;
    if (comp == 1) {
#pragma unroll
        for (int d = 0; d < 4; ++d)
#pragma unroll
            for (int i = 0; i < 16; ++i) X[(w4 * 64 + d * 16 + i) * 64 + lane] = o[d][i] * inv;
    }
    __syncthreads();
    if (comp == 0) {
        float ss = 0.f;
#pragma unroll
        for (int d = 0; d < 4; ++d)
#pragma unroll
            for (int i = 0; i < 16; ++i) { const float v = o[d][i] * inv - lam * X[(w4 * 64 + d * 16 + i) * 64 + lane]; o[d][i] = v; ss += v * v; }
        ss += __shfl_xor(ss, 32);
        const float rstd = rsqrtf(ss * (1.0f / 128.0f) + EPS) * 0.8f;
        bf16* orow = OB + (rowbase + q0 + 32 * w4 + r) * 512 + h * 128;
#pragma unroll
        for (int d = 0; d < 4; ++d)
#pragma unroll
            for (int g4 = 0; g4 < 4; ++g4) { const int dd = 32 * d + 8 * g4 + 4 * hh; const f32x4 gn = *(const f32x4*)(A.diff_norm + dd);
                v2u w; w.x = pk2(o[d][4 * g4 + 0] * rstd * gn.x, o[d][4 * g4 + 1] * rstd * gn.y); w.y = pk2(o[d][4 * g4 + 2] * rstd * gn.z, o[d][4 * g4 + 3] * rstd * gn.w);
                *(v2u*)(orow + dd) = w; }
    }
    __syncthreads();
}

__device__ __forceinline__ void p4_post(const Args& A) {
    int tid_ = threadIdx.x; asm volatile("" : "+v"(tid_)); const int tid = tid_, lane = tid & 63, wave = tid >> 6;
    unsigned char* ws = A.ws;
    const float* oraw = (const float*)(ws + WS_SEG); const bf16* Z = (const bf16*)(ws + WS_SEG) + (size_t)3 * SEG; bf16* OA = (bf16*)(ws + WS_SEG) + (size_t)2 * SEG;
    const int gw = blockIdx.x * 8 + wave, NGW = gridDim.x * 8;
    const int d0 = (lane & 15) * 8;
    float gn[8];
#pragma unroll
    for (int e = 0; e < 8; ++e) gn[e] = A.gdn_norm[d0 + e];
    for (int m0r = gw; m0r < M; m0r += 4 * NGW) {
        f32x4 a0v[4], a1v[4]; v4u zv[4];
#pragma unroll
        for (int q4 = 0; q4 < 4; ++q4) { const int m = m0r + q4 * NGW; a0v[q4] = *(const f32x4*)(oraw + (size_t)m * 512 + 8 * lane); a1v[q4] = *(const f32x4*)(oraw + (size_t)m * 512 + 8 * lane + 4); zv[q4] = *(const v4u*)(Z + (size_t)m * 512 + 8 * lane); }
#pragma unroll
        for (int q4 = 0; q4 < 4; ++q4) { const int m = m0r + q4 * NGW; const f32x4 a0 = a0v[q4], a1 = a1v[q4];
        float v[8] = {a0.x, a0.y, a0.z, a0.w, a1.x, a1.y, a1.z, a1.w};
        float ss = 0.f;
#pragma unroll
        for (int e = 0; e < 8; ++e) ss += v[e] * v[e];
        ss += dpp_xor1(ss); ss += dpp_xor2(ss); ss += dpp_hmirror(ss); ss += dpp_rmirror(ss);
        const float rstd = rsqrtf(ss * (1.0f / 128.0f) + EPS);
        const v4u zr = zv[q4];
        const float z[8] = {bflo(zr.x), bfhi(zr.x), bflo(zr.y), bfhi(zr.y), bflo(zr.z), bfhi(zr.z), bflo(zr.w), bfhi(zr.w)};
#pragma unroll
        for (int e = 0; e < 8; ++e) v[e] = v[e] * rstd * gn[e] * silu(z[e]);
        v4u o; o.x = pk2(v[0], v[1]); o.y = pk2(v[2], v[3]); o.z = pk2(v[4], v[5]); o.w = pk2(v[6], v[7]);
        *(v4u*)(OA + (size_t)m * 512 + 8 * lane) = o;
        }
    }
}

#define XB_TMO      128
#define XB_XCNT(j)  (256  + 64 * (j))
#define XB_XSUB(j)  (1280 + 64 * (j))
#define XB_XGEN(j)  (2304 + 64 * (j))
#define XB_TOP      3328
#define XB_TOPGEN   3392
#define XCD_BAR_WORDS 3456
#define XB_SPIN_CAP (1u << 18)

__device__ __forceinline__ unsigned xb_ld(unsigned* p)              { return __hip_atomic_load(p, __ATOMIC_RELAXED, __HIP_MEMORY_SCOPE_AGENT); }
__device__ __forceinline__ unsigned xb_add(unsigned* p, unsigned v) { return __hip_atomic_fetch_add(p, v, __ATOMIC_RELAXED, __HIP_MEMORY_SCOPE_AGENT); }
__device__ __forceinline__ unsigned xb_xcc_id() { return (unsigned)__builtin_amdgcn_s_getreg((3 << 11) | 20) & 0xFu; }
#define XB_SPIN(cond, bar) do { unsigned _sp = 0; while (cond) { __builtin_amdgcn_s_sleep(1); \
    if ((++_sp & 255u) == 0u) { if (xb_ld(&(bar)[XB_TMO])) break; if (_sp > XB_SPIN_CAP) { atomicAdd(&(bar)[XB_TMO], 1u); break; } } } } while (0)

struct XcdBarrier {
    unsigned* bar; unsigned x;
    volatile LAS unsigned* st;
};

__device__ __forceinline__ XcdBarrier xcd_barrier_post(unsigned* bar, volatile LAS unsigned* st) {
    XcdBarrier b; b.bar = bar; b.x = xb_xcc_id(); b.st = st;
    if (threadIdx.x == 0) (void)xb_add(&bar[XB_XCNT(b.x)], 1u);
    return b;
}
__device__ __forceinline__ void xcd_barrier_complete(unsigned* bar, unsigned x, unsigned& nloc, unsigned& nx) {
    const unsigned G = gridDim.x * gridDim.y * gridDim.z;
    unsigned sum, cnt, mine, sp = 0u;
    for (;;) {
        sum = 0u; cnt = 0u; mine = 0u;
#pragma unroll
        for (unsigned j = 0; j < 16; ++j) { const unsigned c = xb_ld(&bar[XB_XCNT(j)]); sum += c; cnt += (c > 0u) ? 1u : 0u; mine = (j == x) ? c : mine; }
        if (sum == G) break;
        __builtin_amdgcn_s_sleep(1);
        if ((++sp & 255u) == 0u) { if (xb_ld(&bar[XB_TMO])) break; if (sp > XB_SPIN_CAP) { atomicAdd(&bar[XB_TMO], 1u); break; } }
    }
    nloc = mine > 0u ? mine : 1u; nx = cnt > 0u ? cnt : 1u;
}

__device__ __forceinline__ void xcd_barrier(const XcdBarrier& b) {
    asm volatile("s_waitcnt vmcnt(0)" ::: "memory");
    __syncthreads();
    if (threadIdx.x == 0) {
        unsigned* bar = b.bar;
        __builtin_amdgcn_s_waitcnt(0);
        unsigned nloc = b.st[0], nx = b.st[1];
        if (nloc == 0u) { xcd_barrier_complete(bar, b.x, nloc, nx); b.st[0] = nloc; b.st[1] = nx; }
        const unsigned old = xb_add(&bar[XB_XSUB(b.x)], 1u);
        const unsigned gen = old / nloc;
        if (old + 1u == (gen + 1u) * nloc) {
            __builtin_amdgcn_fence(__ATOMIC_RELEASE, "agent");
            asm volatile("s_waitcnt vmcnt(0)" ::: "memory");
            const unsigned og = xb_add(&bar[XB_TOP], 1u);
            const unsigned tg = og / nx;
            if (og + 1u == (tg + 1u) * nx) xb_add(&bar[XB_TOPGEN], 1u);
            else XB_SPIN(xb_ld(&bar[XB_TOPGEN]) == tg, bar);
            __builtin_amdgcn_fence(__ATOMIC_ACQUIRE, "agent");
            xb_add(&bar[XB_XGEN(b.x)], 1u);
            asm volatile("s_waitcnt vmcnt(0)" ::: "memory");
        } else {
            XB_SPIN(xb_ld(&bar[XB_XGEN(b.x)]) == gen, bar);
            __builtin_amdgcn_fence(__ATOMIC_ACQUIRE, "agent");
            asm volatile("s_waitcnt vmcnt(0)" ::: "memory");
        }
    }
    __syncthreads();
}

__global__ void __launch_bounds__(512, 2) mega_fwd(Args A) {
    extern __shared__ __attribute__((aligned(16))) unsigned char lds[];
    cg::grid_group grid = cg::this_grid();
    const int tid = threadIdx.x;
    unsigned char* ws = A.ws;
    PG8_LAS unsigned char* glds = (PG8_LAS unsigned char*)lds;
    bf16* SG = (bf16*)(ws + WS_SEG);
    float* ss2 = (float*)(ws + WS_CTL + 65536); float* ss3 = (float*)(ws + WS_CTL + 262144);
    const int G = gridDim.x, c = blockIdx.x;

    if (tid == 0) { ((volatile LAS unsigned*)((LAS unsigned char*)lds + LDS_MISC))[8] = 0u; ((volatile LAS unsigned*)((LAS unsigned char*)lds + LDS_MISC))[9] = 0u; }
    __syncthreads();
    const XcdBarrier xbar = xcd_barrier_post((unsigned*)(ws + WS_BAR), (volatile LAS unsigned*)((LAS unsigned char*)lds + LDS_MISC) + 8);
#ifndef NO_P0
    p0_prologue(A, lds);
#ifdef DBL_P0
    __syncthreads();
    p0_prologue(A, lds);
#endif
#endif
    xcd_barrier(xbar);
    if (ws == nullptr) grid.sync();
#define GSYNC() xcd_barrier(xbar)
    { pg8::Gemm g{(const bf16*)(ws + WS_XN), (const bf16*)(ws + WS_WIN), M, NP, D}; pg8::StaticOrder S; S.init(M, NP, G, c);
      pg8::EpiSplit E{SG}; pg8::gemm_phase<pg8::EpiSplit, pg8::StaticOrder, true, true>(glds, g, S, E);
#ifdef DBL_G15
      pg8::gemm_phase<pg8::EpiSplit, pg8::StaticOrder, true, true>(glds, g, S, E);
#endif
    }
    GSYNC();
#ifdef DBG_FILL
    { v4u z = (v4u){0u,0u,0u,0u};
      v4u* p1 = (v4u*)(ws + WS_XN); for (size_t i = (size_t)c * 512 + tid; i < (64 * MiB) / 16; i += (size_t)G * 512) p1[i] = z;
      v4u* p2 = (v4u*)A.out; for (size_t i = (size_t)c * 512 + tid; i < (128 * MiB) / 16; i += (size_t)G * 512) p2[i] = z; }
    GSYNC();
#endif
    bf16 rawp[3][19]; float cwp[3][4], gbp[2];
    if (c < 2048) GDN_LOAD_RAW(rawp, cwp, gbp, c);
    for (int u = c; u < 2048 + 512; u += G) {
#ifndef NO_P2A
        if (u < 2048) gdn_pre_unit(A, lds, u, rawp, cwp, gbp, u + G);
#endif
#ifndef NO_P2B
        if (u >= 2048) diff_prep_unit(A, lds, u - 2048);
#endif
    }
    GSYNC();
#ifndef NO_P3
    {
        float mq = fabsf(A.q_norm[tid & 63]), mk = fabsf(A.k_norm[tid & 63]);
        float l1 = A.lq1[tid & 63] * A.lk1[tid & 63], l2 = A.lq2[tid & 63] * A.lk2[tid & 63];
#pragma unroll
        for (int o = 1; o < 64; o <<= 1) { mq = fmaxf(mq, __shfl_xor(mq, o)); mk = fmaxf(mk, __shfl_xor(mk, o)); l1 += __shfl_xor(l1, o); l2 += __shfl_xor(l2, o); }
        const float negshift = -(8.0f * mq * mk * 1.4426950408889634f + 0.5f);
        const float lam = expf(l1) - expf(l2) + 0.2f;
        LAS unsigned* misc = (LAS unsigned*)((LAS unsigned char*)lds + LDS_MISC);
        unsigned* qctr = (unsigned*)(ws + WS_CTL);
        for (;;) {
            if (tid == 0) misc[0] = atomicAdd(qctr, 1u);
            __syncthreads();
            const int it = (int)misc[0];
            __syncthreads();
            if (it >= NQ_GDN + NQ_ATT) break;
            if (it < NQ_GDN) gdn_scan_item(A, lds, it);
            else { const int j = it - NQ_GDN; attn_unit(A, lds, j & 15, 63 - (j >> 4), negshift, lam); }
        }
    }
#endif
    GSYNC();
#ifdef DBG_P2A_DIGEST
    { const bf16* qd = (const bf16*)(ws + WS_XN); const bf16* kd = (const bf16*)(ws + WS_XN + 32 * MiB);
      const bf16* ub = (const bf16*)((unsigned char*)A.out + DO_U); const bf16* wb = (const bf16*)((unsigned char*)A.out + DO_W); const bf16* ab = (const bf16*)((unsigned char*)A.out + DO_A);
      const float* eg = (const float*)(ws + WS_CTL + 524288);
      bf16* OA = SG + 2 * SEG;
      for (size_t i = (size_t)c * 512 + tid; i < SEG; i += (size_t)G * 512) {
          float v = bf2f(qd[i]) + bf2f(kd[i]) + bf2f(ub[i]) + bf2f(wb[i]) + bf2f(ab[i >> 1]) + eg[(i & 2047) * 32];
          OA[i] = (bf16)f2bf(v); } }
#endif
#ifndef NO_P4
    p4_post(A);
#endif
    GSYNC();
    { pg8::StaticOrder S; S.init(M, D, G, c);
      { pg8::Gemm g{SG + 2 * SEG, (const bf16*)(ws + WS_WOA), M, D, 512}; pg8::EpiGate<false> E{SG + 7 * SEG, (bf16*)(ws + WS_XN)};
        pg8::gemm_phase<pg8::EpiGate<false>, pg8::StaticOrder, true, true>(glds, g, S, E); }
      { pg8::Gemm g{SG + 6 * SEG, (const bf16*)(ws + WS_WOB), M, D, 512}; pg8::EpiGate<true> E{SG + 9 * SEG, (bf16*)(ws + WS_XN)};
        pg8::gemm_phase<pg8::EpiGate<true>, pg8::StaticOrder, true, true>(glds, g, S, E); } }
    GSYNC();
    { pg8::Gemm g{(const bf16*)(ws + WS_XN), (const bf16*)(ws + WS_WOUT), M, D, D}; pg8::StaticOrder S; S.init(M, D, G, c);
      pg8::EpiResB<false> E{A.x, SG + 8 * SEG, ss2}; pg8::gemm_phase<pg8::EpiResB<false>, pg8::StaticOrder, true, true>(glds, g, S, E); }
    GSYNC();
    { pg8::Gemm g{SG + 8 * SEG, (const bf16*)(ws + WS_WUP), M, FF, D}; pg8::StaticOrder S; S.init(M, FF, G, c);
      pg8::EpiUp E{SG, ss2}; pg8::gemm_phase<pg8::EpiUp, pg8::StaticOrder, true, true>(glds, g, S, E);
#ifdef DBL_G15
      pg8::gemm_phase<pg8::EpiUp, pg8::StaticOrder, true, true>(glds, g, S, E);
#endif
    }
    GSYNC();
    { pg8::Gemm g{SG, (const bf16*)(ws + WS_WDN), M, D, FF}; pg8::StaticOrder S; S.init(M, D, G, c);
      pg8::EpiResB<true> E{SG + 8 * SEG, (bf16*)(ws + WS_XN), ss3}; pg8::gemm_phase<pg8::EpiResB<true>, pg8::StaticOrder, true, true>(glds, g, S, E); }
    GSYNC();
    { pg8::StaticOrder S; S.init(M, D, G, c);
      { pg8::Gemm g{(const bf16*)(ws + WS_PBF), (const bf16*)(ws + WS_WPLE), M, D, PLE}; pg8::EpiBf E{SG};
        pg8::gemm_phase<pg8::EpiBf, pg8::StaticOrder, true, true>(glds, g, S, E); }
      { pg8::Gemm g{(const bf16*)(ws + WS_XN), (const bf16*)(ws + WS_WPG), M, D, D}; pg8::EpiPleB E{A.out, (const bf16*)(ws + WS_XN), SG, ss3};
        pg8::gemm_phase<pg8::EpiPleB, pg8::StaticOrder, true, true>(glds, g, S, E); } }
}

extern "C" void kernel_launch(void* const* d_in, const int* in_sizes, int n_in, void* d_out, int out_size, void* d_ws, size_t ws_size, hipStream_t stream) {
    static int grid = 0;
    if (grid == 0) {
        if (n_in != 25 || ws_size < WS_END || out_size != M * D) { fprintf(stderr, "kernel_launch: unexpected shapes (n_in %d, ws %zu, out %d)\n", n_in, ws_size, out_size); grid = -1; return; }
        int dev = 0, cus = 0, per_cu = 0;
        hipGetDevice(&dev); hipDeviceGetAttribute(&cus, hipDeviceAttributeMultiprocessorCount, dev);
        hipFuncSetAttribute((const void*)mega_fwd, hipFuncAttributeMaxDynamicSharedMemorySize, LDS_BYTES);
        hipOccupancyMaxActiveBlocksPerMultiprocessor(&per_cu, (const void*)mega_fwd, 512, LDS_BYTES);
        (void)hipGetLastError();
        if (per_cu < 1) per_cu = 1;
        grid = cus * 1;
    }
    if (grid < 0) return;
    Args a{};
    a.x = (const float*)d_in[0]; a.p = (const float*)d_in[1]; a.pos = (const int*)d_in[2]; a.attn_norm = (const float*)d_in[3]; a.w_in = (const float*)d_in[4];
    a.conv_w = (const float*)d_in[5]; a.a_log = (const float*)d_in[6]; a.dt_bias = (const float*)d_in[7]; a.gdn_norm = (const float*)d_in[8]; a.w_o_a = (const float*)d_in[9];
    a.q_norm = (const float*)d_in[10]; a.k_norm = (const float*)d_in[11]; a.lq1 = (const float*)d_in[12]; a.lk1 = (const float*)d_in[13]; a.lq2 = (const float*)d_in[14]; a.lk2 = (const float*)d_in[15];
    a.diff_norm = (const float*)d_in[16]; a.w_o_b = (const float*)d_in[17]; a.w_out = (const float*)d_in[18]; a.mlp_norm = (const float*)d_in[19]; a.w_up = (const float*)d_in[20];
    a.w_down = (const float*)d_in[21]; a.ple_norm = (const float*)d_in[22]; a.w_ple_gate = (const float*)d_in[23]; a.w_ple = (const float*)d_in[24];
    a.out = (float*)d_out; a.ws = (unsigned char*)d_ws;
    (void)hipMemsetAsync(d_ws, 0, 1 * MiB, stream);
    void* args[] = {&a};
    hipError_t e = hipLaunchCooperativeKernel((const void*)mega_fwd, dim3(grid), dim3(512), args, LDS_BYTES, stream);
    if (e != hipSuccess) fprintf(stderr, "cooperative launch failed: %s (grid %d)\n", hipGetErrorString(e), grid);
}
```

```cpp
#include <hip/hip_runtime.h>
#include <hip/hip_cooperative_groups.h>
#include <cstdio>
#include <cstdint>
namespace cg = cooperative_groups;
namespace pg8 {
#define PG8_LAS __attribute__((address_space(3)))
typedef unsigned short bf16_t;
typedef short bf16x8 __attribute__((ext_vector_type(8)));
typedef float f32x4 __attribute__((ext_vector_type(4)));
typedef unsigned u32x4 __attribute__((ext_vector_type(4)));
constexpr int BM = 256, BK = 64, HALF = 128, HTB = HALF * BK * 2  , STAGE_BYTES = 8 * HTB, NXCD = 8, WGM = 8;

__host__ __device__ __forceinline__ int lds_byte(int r, int c) { const int st = (r >> 4) * 2 + (c >> 5), rr = r & 15, cc = c & 31, ob = rr * 64 + cc * 2; return st * 1024 + (ob ^ (((ob >> 9) & 1) << 5)); }
__host__ __device__ __forceinline__ void stage_rc(int b, int& R, int& C) { const int st = b / 1024, sb = b % 1024, swz = sb ^ (((sb >> 9) & 1) << 5); R = (st >> 1) * 16 + swz / 64; C = (st & 1) * 32 + (swz % 64) / 2; }
__host__ __device__ __forceinline__ int perm32(int rho) { const int n = rho >> 4, i = rho & 15; return 8 * (i >> 2) + 4 * n + (i & 3); }

struct Unit { int pm, pn; };
struct Gemm { const bf16_t* A; const bf16_t* Bt; int M, N, K; };

struct StaticOrder {
    int nM, nN, nwg, G, c;
    __host__ __device__ void init(int M, int N, int G_, int c_) { nM = M / BM; nN = N / BM; nwg = nM * nN; G = G_; c = c_; }
    __host__ __device__ bool next(int i, Unit& u) const {
        const long L = (long)i * G + c; if (L >= nwg) return false;
        int wgid = (int)L; { const int q = nwg / NXCD, r = nwg % NXCD, xcd = wgid % NXCD, off = wgid / NXCD; wgid = (xcd < r ? xcd * (q + 1) : r * (q + 1) + (xcd - r) * q) + off; }
        const int nig = WGM * nN, gid = wgid / nig, fm = gid * WGM, gsz = (nM - fm) < WGM ? (nM - fm) : WGM;
        u.pm = fm + ((wgid % nig) % gsz); u.pn = (wgid % nig) / gsz; return true;
    }
    __device__ __forceinline__ void a_ready(const Unit&) const {}
    __device__ __forceinline__ void done(const Unit&) const {}
};

__device__ __forceinline__ unsigned cvt_pk_bf16(float lo, float hi) { unsigned r; asm volatile("v_cvt_pk_bf16_f32 %0, %1, %2" : "=v"(r) : "v"(lo), "v"(hi)); return r; }
typedef float f32x2 __attribute__((ext_vector_type(2)));
constexpr int EM = 32768;
constexpr size_t ESEG = (size_t)EM * 512;
__device__ __forceinline__ float bf2f(unsigned short b) { return __uint_as_float((unsigned)b << 16); }
__device__ __forceinline__ float bflo(unsigned w) { return __uint_as_float(w << 16); }
__device__ __forceinline__ float bfhi(unsigned w) { return __uint_as_float(w & 0xffff0000u); }
__device__ __forceinline__ float sigm(float x) { return 1.0f / (1.0f + __expf(-x)); }
__device__ __forceinline__ u32x4 pack8(const f32x4& v0, const f32x4& v1) { u32x4 w; w.x = cvt_pk_bf16(v0[0], v0[1]); w.y = cvt_pk_bf16(v0[2], v0[3]); w.z = cvt_pk_bf16(v1[0], v1[1]); w.w = cvt_pk_bf16(v1[2], v1[3]); return w; }
__device__ __forceinline__ void unpack8(const u32x4& w, f32x4& v0, f32x4& v1) { v0 = (f32x4){bflo(w.x), bfhi(w.x), bflo(w.y), bfhi(w.y)}; v1 = (f32x4){bflo(w.z), bfhi(w.z), bflo(w.w), bfhi(w.w)}; }

struct EpiSplit {
    static constexpr bool PERM = true, AFTER_DRAIN = false;
    bf16_t* O;
    __device__ __forceinline__ void operator()(const f32x4 (&acc)[2][2][4][2], const Unit& u, int wr, int wc, int fr, int fq) const {
        const int row0 = u.pm * BM + wr * 64 + fr; const int colt = u.pn * BM; const int seg = colt >> 9, cin = colt & 511;
        bf16_t* base = O + (size_t)seg * ESEG + cin + wc * 32 + 8 * fq;
#pragma unroll
        for (int ai = 0; ai < 2; ++ai)
#pragma unroll
            for (int m = 0; m < 4; ++m) { asm volatile("" ::: "memory"); bf16_t* rowp = base + (size_t)(row0 + ai * HALF + m * 16) * 512;
#pragma unroll
                for (int bj = 0; bj < 2; ++bj) *(u32x4*)(rowp + bj * HALF) = pack8(acc[ai][bj][m][0], acc[ai][bj][m][1]); }
    }
};
template <bool ADD> struct EpiGate {
    static constexpr bool PERM = true, AFTER_DRAIN = false;
    const bf16_t* G; bf16_t* Tt;
    __device__ __forceinline__ void operator()(const f32x4 (&acc)[2][2][4][2], const Unit& u, int wr, int wc, int fr, int fq) const {
        const int row0 = u.pm * BM + wr * 64 + fr; const int colt = u.pn * BM; const int seg = colt >> 9, cin = colt & 511;
        const bf16_t* gbase = G + (size_t)seg * ESEG + cin + wc * 32 + 8 * fq;
        bf16_t* tbase = Tt + colt + wc * 32 + 8 * fq;
#pragma unroll
        for (int ai = 0; ai < 2; ++ai)
#pragma unroll
            for (int m = 0; m < 4; ++m) { asm volatile("" ::: "memory"); const size_t row = (size_t)(row0 + ai * HALF + m * 16);
#pragma unroll
                for (int bj = 0; bj < 2; ++bj) {
                    const u32x4 gw = *(const u32x4*)(gbase + row * 512 + bj * HALF); f32x4 g0, g1; unpack8(gw, g0, g1);
                    f32x4 v0 = acc[ai][bj][m][0], v1 = acc[ai][bj][m][1];
#pragma unroll
                    for (int e = 0; e < 4; ++e) { v0[e] *= sigm(g0[e]); v1[e] *= sigm(g1[e]); }
                    bf16_t* tp = tbase + row * 1024 + bj * HALF;
                    if (ADD) { const u32x4 tw = *(const u32x4*)tp; f32x4 t0, t1; unpack8(tw, t0, t1); v0 += t0; v1 += t1; }
                    *(u32x4*)tp = pack8(v0, v1); } }
    }
};
struct EpiRes {
    static constexpr bool PERM = true, AFTER_DRAIN = false;
    const float* base; float* out; bf16_t* XB; float* SS;
    __device__ __forceinline__ void operator()(const f32x4 (&acc)[2][2][4][2], const Unit& u, int wr, int wc, int fr, int fq) const {
        const int row0 = u.pm * BM + wr * 64 + fr; const int col0 = u.pn * BM + wc * 32 + 8 * fq;
#pragma unroll
        for (int ai = 0; ai < 2; ++ai)
#pragma unroll
            for (int m = 0; m < 4; ++m) { asm volatile("" ::: "memory"); const size_t row = (size_t)(row0 + ai * HALF + m * 16); float ss = 0.f;
#pragma unroll
                for (int bj = 0; bj < 2; ++bj) { const size_t off = row * 1024 + col0 + bj * HALF;
                    const f32x4 b0 = *(const f32x4*)(base + off), b1 = *(const f32x4*)(base + off + 4);
                    const f32x4 v0 = acc[ai][bj][m][0] + b0, v1 = acc[ai][bj][m][1] + b1;
                    *(f32x4*)(out + off) = v0; *(f32x4*)(out + off + 4) = v1;
                    *(u32x4*)(XB + off) = pack8(v0, v1);
                    ss += (v0[0] * v0[0] + v0[1] * v0[1]) + (v0[2] * v0[2] + v0[3] * v0[3]) + (v1[0] * v1[0] + v1[1] * v1[1]) + (v1[2] * v1[2] + v1[3] * v1[3]); }
                ss += __shfl_xor(ss, 16); ss += __shfl_xor(ss, 32);
                if (fq == 0) atomicAdd(SS + row, ss); }
    }
};
struct EpiUp {
    static constexpr bool PERM = true, AFTER_DRAIN = false;
    bf16_t* U; const float* SS;
    __device__ __forceinline__ void operator()(const f32x4 (&acc)[2][2][4][2], const Unit& u, int wr, int wc, int fr, int fq) const {
        const int row0 = u.pm * BM + wr * 64 + fr; const int col0 = u.pn * BM + wc * 32 + 8 * fq;
#pragma unroll
        for (int ai = 0; ai < 2; ++ai)
#pragma unroll
            for (int m = 0; m < 4; ++m) { asm volatile("" ::: "memory"); const size_t row = (size_t)(row0 + ai * HALF + m * 16);
                const float rstd = rsqrtf(SS[row] * (1.0f / 1024.0f) + 1e-6f);
#pragma unroll
                for (int bj = 0; bj < 2; ++bj) { f32x4 v0 = acc[ai][bj][m][0] * rstd, v1 = acc[ai][bj][m][1] * rstd;
#pragma unroll
                    for (int e = 0; e < 4; ++e) { const float a = fmaxf(v0[e], 0.f), b = fmaxf(v1[e], 0.f); v0[e] = a * a; v1[e] = b * b; }
                    *(u32x4*)(U + row * 4096 + col0 + bj * HALF) = pack8(v0, v1); } }
    }
};
struct EpiF32 {
    static constexpr bool PERM = false, AFTER_DRAIN = false;
    float* O;
    __device__ __forceinline__ void operator()(const f32x4 (&acc)[2][2][4][2], const Unit& u, int wr, int wc, int fr, int fq) const {
        const int row0 = u.pm * BM + wr * 64 + fr; const int col0 = u.pn * BM + wc * 32 + 4 * fq;
#pragma unroll
        for (int ai = 0; ai < 2; ++ai)
#pragma unroll
            for (int m = 0; m < 4; ++m) { asm volatile("" ::: "memory"); const size_t row = (size_t)(row0 + ai * HALF + m * 16);
#pragma unroll
                for (int bj = 0; bj < 2; ++bj)
#pragma unroll
                    for (int n = 0; n < 2; ++n) *(f32x4*)(O + row * 1024 + col0 + bj * HALF + n * 16) = acc[ai][bj][m][n]; }
    }
};
struct EpiPle {
    static constexpr bool PERM = false, AFTER_DRAIN = false;
    float* out; const float* P; const float* SS;
    __device__ __forceinline__ void operator()(const f32x4 (&acc)[2][2][4][2], const Unit& u, int wr, int wc, int fr, int fq) const {
        const int row0 = u.pm * BM + wr * 64 + fr; const int col0 = u.pn * BM + wc * 32 + 4 * fq;
#pragma unroll
        for (int ai = 0; ai < 2; ++ai)
#pragma unroll
            for (int m = 0; m < 4; ++m) { asm volatile("" ::: "memory"); const size_t row = (size_t)(row0 + ai * HALF + m * 16);
                const float rstd = rsqrtf(SS[row] * (1.0f / 1024.0f) + 1e-6f);
#pragma unroll
                for (int bj = 0; bj < 2; ++bj)
#pragma unroll
                    for (int n = 0; n < 2; ++n) { const size_t off = row * 1024 + col0 + bj * HALF + n * 16;
                        const f32x4 x = *(const f32x4*)(out + off), pl = *(const f32x4*)(P + off); f32x4 v = acc[ai][bj][m][n] * rstd;
#pragma unroll
                        for (int e = 0; e < 4; ++e) v[e] = x[e] + sigm(v[e]) * pl[e];
                        *(f32x4*)(out + off) = v; } }
    }
};

template <bool BASE_BF16> struct EpiResB {
    static constexpr bool PERM = true, AFTER_DRAIN = false;
    const void* base; bf16_t* XB; float* SS;
    __device__ __forceinline__ void operator()(const f32x4 (&acc)[2][2][4][2], const Unit& u, int wr, int wc, int fr, int fq) const {
        const int row0 = u.pm * BM + wr * 64 + fr; const int col0 = u.pn * BM + wc * 32 + 8 * fq;
#pragma unroll
        for (int ai = 0; ai < 2; ++ai)
#pragma unroll
            for (int m = 0; m < 4; ++m) { asm volatile("" ::: "memory"); const size_t row = (size_t)(row0 + ai * HALF + m * 16); float ss = 0.f;
#pragma unroll
                for (int bj = 0; bj < 2; ++bj) { const size_t off = row * 1024 + col0 + bj * HALF; f32x4 b0, b1;
                    if (BASE_BF16) { const u32x4 bw = *(const u32x4*)((const bf16_t*)base + off); unpack8(bw, b0, b1); }
                    else { b0 = *(const f32x4*)((const float*)base + off); b1 = *(const f32x4*)((const float*)base + off + 4); }
                    const f32x4 v0 = acc[ai][bj][m][0] + b0, v1 = acc[ai][bj][m][1] + b1;
                    *(u32x4*)(XB + off) = pack8(v0, v1);
                    ss += (v0[0] * v0[0] + v0[1] * v0[1]) + (v0[2] * v0[2] + v0[3] * v0[3]) + (v1[0] * v1[0] + v1[1] * v1[1]) + (v1[2] * v1[2] + v1[3] * v1[3]); }
                ss += __shfl_xor(ss, 16); ss += __shfl_xor(ss, 32);
                if (fq == 0) atomicAdd(SS + row, ss); }
    }
};
struct EpiBf {
    static constexpr bool PERM = true, AFTER_DRAIN = false;
    bf16_t* O;
    __device__ __forceinline__ void operator()(const f32x4 (&acc)[2][2][4][2], const Unit& u, int wr, int wc, int fr, int fq) const {
        const int row0 = u.pm * BM + wr * 64 + fr; const int col0 = u.pn * BM + wc * 32 + 8 * fq;
#pragma unroll
        for (int ai = 0; ai < 2; ++ai)
#pragma unroll
            for (int m = 0; m < 4; ++m) { asm volatile("" ::: "memory"); const size_t row = (size_t)(row0 + ai * HALF + m * 16);
#pragma unroll
                for (int bj = 0; bj < 2; ++bj) *(u32x4*)(O + row * 1024 + col0 + bj * HALF) = pack8(acc[ai][bj][m][0], acc[ai][bj][m][1]); }
    }
};
struct EpiPleB {
    static constexpr bool PERM = true, AFTER_DRAIN = false;
    float* out; const bf16_t* XB; const bf16_t* P; const float* SS;
    __device__ __forceinline__ void operator()(const f32x4 (&acc)[2][2][4][2], const Unit& u, int wr, int wc, int fr, int fq) const {
        const int row0 = u.pm * BM + wr * 64 + fr; const int col0 = u.pn * BM + wc * 32 + 8 * fq;
#pragma unroll
        for (int ai = 0; ai < 2; ++ai)
#pragma unroll
            for (int m = 0; m < 4; ++m) { asm volatile("" ::: "memory"); const size_t row = (size_t)(row0 + ai * HALF + m * 16);
                const float rstd = rsqrtf(SS[row] * (1.0f / 1024.0f) + 1e-6f);
#pragma unroll
                for (int bj = 0; bj < 2; ++bj) { const size_t off = row * 1024 + col0 + bj * HALF;
                    const u32x4 xw = *(const u32x4*)(XB + off), pw = *(const u32x4*)(P + off); f32x4 x0, x1, p0, p1; unpack8(xw, x0, x1); unpack8(pw, p0, p1);
                    f32x4 v0 = acc[ai][bj][m][0] * rstd, v1 = acc[ai][bj][m][1] * rstd;
#pragma unroll
                    for (int e2 = 0; e2 < 4; ++e2) { v0[e2] = x0[e2] + sigm(v0[e2]) * p0[e2]; v1[e2] = x1[e2] + sigm(v1[e2]) * p1[e2]; }
                    *(f32x4*)(out + off) = v0; *(f32x4*)(out + off + 4) = v1; } }
    }
};
template <class Epi, class Sched, bool ALIGN_EPI = false, bool SP2 = false>
__device__ __forceinline__ void gemm_phase(PG8_LAS unsigned char* lds, const Gemm g, const Sched& S, const Epi& E) {
    int tid_ = threadIdx.x; asm volatile("" : "+v"(tid_)); const int tid = tid_, wid = __builtin_amdgcn_readfirstlane(tid >> 6), lane = tid & 63, wr = wid >> 2, wc = wid & 3, fr = lane & 15, fq = lane >> 4;
    const int K = g.K, nt = K / BK;
    unsigned voffA[2], voffB[2];
#pragma unroll
    for (int i = 0; i < 2; ++i) { int R, C; stage_rc(tid * 16 + i * 8192, R, C); const int Rb = Epi::PERM ? ((R & ~31) + perm32(R & 31)) : R;
        voffA[i] = (unsigned)(R * K + C) * 2u; voffB[i] = (unsigned)(Rb * K + C) * 2u; }
    const size_t kstep = (size_t)(BK * 2);
    const size_t hstep = (size_t)HALF * K * 2;
    const size_t tstep = 2 * hstep;
    const unsigned ldsw = (unsigned)wid * 1024u;
    const int aoff = lds_byte(wr * 64 + fr, fq * 8), boff = lds_byte(wc * 32 + fr, fq * 8);
#define PG8_SA(b, h) (((b) * 2 + (h)) * HTB)
#define PG8_SB(b, h) ((4 + (b) * 2 + (h)) * HTB)
#define PG8_STAGE(bufoff, gbase, voff) do { _Pragma("unroll") for (int _i = 0; _i < 2; ++_i) \
        __builtin_amdgcn_global_load_lds((const unsigned*)((const char*)(gbase) + (voff)[_i]), (PG8_LAS unsigned*)(lds + (bufoff) + ldsw + _i * 8192), 16, 0, 0); } while (0)
#define PG8_LDA(dst, b, h) do { _Pragma("unroll") for (int m = 0; m < 4; ++m) _Pragma("unroll") for (int k = 0; k < 2; ++k) dst[m][k] = *(const PG8_LAS bf16x8*)(lds + PG8_SA(b, h) + aoff + m * 2048 + k * 1024); } while (0)
#define PG8_LDB(dst, b, h) do { _Pragma("unroll") for (int n = 0; n < 2; ++n) _Pragma("unroll") for (int k = 0; k < 2; ++k) dst[n][k] = *(const PG8_LAS bf16x8*)(lds + PG8_SB(b, h) + boff + n * 2048 + k * 1024); } while (0)
#define PG8_MMA(ai, bj, At, Bt) do { __builtin_amdgcn_s_setprio(1); _Pragma("unroll") for (int m = 0; m < 4; ++m) _Pragma("unroll") for (int n = 0; n < 2; ++n) _Pragma("unroll") for (int k = 0; k < 2; ++k) \
        acc[ai][bj][m][n] = __builtin_amdgcn_mfma_f32_16x16x32_bf16(Bt[n][k], At[m][k], acc[ai][bj][m][n], 0, 0, 0); __builtin_amdgcn_s_setprio(0); } while (0)
#define PG8_WAIT_V(n) asm volatile("s_waitcnt vmcnt(" #n ")" ::: "memory")
#define PG8_WAIT_L(n) asm volatile("s_waitcnt lgkmcnt(" #n ")" ::: "memory")
#define PG8_BAR __builtin_amdgcn_s_barrier()
#define PG8_SCHED __builtin_amdgcn_sched_barrier(0)
    Unit cur, nxt; int ui = 0;
    if (!S.next(0, cur)) return;
    f32x4 acc[2][2][4][2];
#pragma unroll
    for (int a = 0; a < 2; ++a)
#pragma unroll
        for (int b = 0; b < 2; ++b)
#pragma unroll
            for (int m = 0; m < 4; ++m)
#pragma unroll
                for (int n = 0; n < 2; ++n) acc[a][b][m][n] = (f32x4){0.f, 0.f, 0.f, 0.f};
    bf16x8 At[4][2], B0[2][2], B1[2][2];
    const char* cA = (const char*)g.A + (size_t)cur.pm * tstep; const char* cB = (const char*)g.Bt + (size_t)cur.pn * tstep;
    S.a_ready(cur);
    if constexpr (SP2) {
        PG8_STAGE(PG8_SB(0, 0), cB, voffB); PG8_STAGE(PG8_SB(0, 1), cB + hstep, voffB); PG8_STAGE(PG8_SA(0, 0), cA, voffA); PG8_STAGE(PG8_SA(0, 1), cA + hstep, voffA);
        if (wr == 1) PG8_BAR;
        PG8_WAIT_V(2); PG8_BAR;
        PG8_STAGE(PG8_SB(1, 0), cB + kstep, voffB); PG8_STAGE(PG8_SA(1, 0), cA + kstep, voffA); PG8_STAGE(PG8_SB(1, 1), cB + hstep + kstep, voffB);
        PG8_WAIT_V(6); PG8_BAR;
    } else {
        PG8_STAGE(PG8_SB(0, 0), cB, voffB); PG8_STAGE(PG8_SA(0, 0), cA, voffA); PG8_STAGE(PG8_SB(0, 1), cB + hstep, voffB); PG8_STAGE(PG8_SA(0, 1), cA + hstep, voffA);
        if (wr == 1) PG8_BAR;
        PG8_WAIT_V(4); PG8_BAR;
        PG8_STAGE(PG8_SB(1, 0), cB + kstep, voffB); PG8_STAGE(PG8_SA(1, 0), cA + kstep, voffA); PG8_STAGE(PG8_SB(1, 1), cB + hstep + kstep, voffB);
        PG8_WAIT_V(6); PG8_BAR;
    }
    for (;;) {
        const bool has_next = S.next(ui + 1, nxt);
        const char* nA = has_next ? (const char*)g.A + (size_t)nxt.pm * tstep : cA; const char* nB = has_next ? (const char*)g.Bt + (size_t)nxt.pn * tstep : cB;
        for (int t = 0; t < nt; t += 2) {
            const bool last = (t == nt - 2);
            const char* a1 = cA + (size_t)(t + 1) * kstep;
            const char* a2 = last ? nA : cA + (size_t)(t + 2) * kstep; const char* b2 = last ? nB : cB + (size_t)(t + 2) * kstep;
            const char* a3 = a2 + kstep; const char* b3 = b2 + kstep;
            if (last && has_next) S.a_ready(nxt);
            if constexpr (SP2) {
            PG8_LDB(B0, 0, 0); PG8_LDB(B1, 0, 1); PG8_SCHED; PG8_LDA(At, 0, 0); PG8_STAGE(PG8_SA(1, 1), a1 + hstep, voffA);
            PG8_WAIT_V(8); PG8_WAIT_L(0); PG8_BAR; PG8_MMA(0, 0, At, B0); PG8_MMA(0, 1, At, B1); PG8_BAR; PG8_SCHED;
            PG8_LDA(At, 0, 1); PG8_STAGE(PG8_SB(0, 0), b2, voffB); PG8_STAGE(PG8_SB(0, 1), b2 + hstep, voffB); PG8_STAGE(PG8_SA(0, 0), a2, voffA);
            PG8_WAIT_V(8); PG8_WAIT_L(0); PG8_BAR; PG8_MMA(1, 0, At, B0); PG8_MMA(1, 1, At, B1); PG8_BAR; PG8_SCHED;
            PG8_LDB(B0, 1, 0); PG8_LDB(B1, 1, 1); PG8_SCHED; PG8_LDA(At, 1, 0); PG8_STAGE(PG8_SA(0, 1), a2 + hstep, voffA);
            PG8_WAIT_V(8); PG8_WAIT_L(0); PG8_BAR; PG8_MMA(0, 0, At, B0); PG8_MMA(0, 1, At, B1); PG8_BAR; PG8_SCHED;
            PG8_LDA(At, 1, 1); PG8_STAGE(PG8_SB(1, 0), b3, voffB); PG8_STAGE(PG8_SB(1, 1), b3 + hstep, voffB); PG8_STAGE(PG8_SA(1, 0), a3, voffA);
            PG8_WAIT_V(8); PG8_WAIT_L(0); PG8_BAR; PG8_MMA(1, 0, At, B0); PG8_MMA(1, 1, At, B1); PG8_BAR; PG8_SCHED;
            } else {
            PG8_LDB(B0, 0, 0); PG8_SCHED; PG8_LDA(At, 0, 0); PG8_STAGE(PG8_SA(1, 1), a1 + hstep, voffA);
            PG8_WAIT_L(8); PG8_BAR; PG8_WAIT_L(0); PG8_MMA(0, 0, At, B0); PG8_BAR; PG8_SCHED;
            PG8_LDB(B1, 0, 1); PG8_STAGE(PG8_SB(0, 0), b2, voffB);
            PG8_BAR; PG8_WAIT_L(0); PG8_MMA(0, 1, At, B1); PG8_BAR;
            PG8_LDA(At, 0, 1); PG8_STAGE(PG8_SA(0, 0), a2, voffA);
            PG8_BAR; PG8_WAIT_L(0); PG8_MMA(1, 0, At, B0); PG8_BAR; PG8_SCHED;
            PG8_STAGE(PG8_SB(0, 1), b2 + hstep, voffB);
            PG8_WAIT_V(6); PG8_BAR; PG8_MMA(1, 1, At, B1); PG8_BAR;
            PG8_LDB(B0, 1, 0); PG8_SCHED; PG8_LDA(At, 1, 0); PG8_STAGE(PG8_SA(0, 1), a2 + hstep, voffA);
            PG8_WAIT_L(8); PG8_BAR; PG8_WAIT_L(0); PG8_MMA(0, 0, At, B0); PG8_BAR; PG8_SCHED;
            PG8_LDB(B1, 1, 1); PG8_STAGE(PG8_SB(1, 0), b3, voffB);
            PG8_BAR; PG8_WAIT_L(0); PG8_MMA(0, 1, At, B1); PG8_BAR;
            PG8_LDA(At, 1, 1); PG8_STAGE(PG8_SA(1, 0), a3, voffA);
            PG8_BAR; PG8_WAIT_L(0); PG8_MMA(1, 0, At, B0); PG8_BAR; PG8_SCHED;
            PG8_STAGE(PG8_SB(1, 1), b3 + hstep, voffB);
            PG8_WAIT_V(6); PG8_BAR; PG8_MMA(1, 1, At, B1); PG8_BAR;
            }
        }
        if constexpr (ALIGN_EPI) { if (wr == 0) PG8_BAR; }
        if constexpr (!Epi::AFTER_DRAIN) { E(acc, cur, wr, wc, fr, fq); S.done(cur); }
        if (!has_next) break;
#pragma unroll
        for (int a = 0; a < 2; ++a)
#pragma unroll
            for (int b = 0; b < 2; ++b)
#pragma unroll
                for (int m = 0; m < 4; ++m)
#pragma unroll
                    for (int n = 0; n < 2; ++n) acc[a][b][m][n] = (f32x4){0.f, 0.f, 0.f, 0.f};
        cur = nxt; cA = nA; cB = nB; ++ui;
        if constexpr (ALIGN_EPI) { if (wr == 1) PG8_BAR; }
    }
    PG8_WAIT_V(0);
    if constexpr (!ALIGN_EPI) { if (wr == 0) PG8_BAR; }
    PG8_BAR;
    if constexpr (Epi::AFTER_DRAIN) { E.fused(acc, cur, wr, wc, fr, fq, lds, wid, lane); S.done(cur); }
#undef PG8_SA
#undef PG8_SB
#undef PG8_STAGE
#undef PG8_LDA
#undef PG8_LDB
#undef PG8_MMA
#undef PG8_WAIT_V
#undef PG8_WAIT_L
#undef PG8_BAR
#undef PG8_SCHED
}
}

#define LAS __attribute__((address_space(3)))
typedef unsigned short bf16;
typedef unsigned v4u __attribute__((ext_vector_type(4)));
typedef unsigned v2u __attribute__((ext_vector_type(2)));
typedef float f32x4 __attribute__((ext_vector_type(4)));
typedef float f32x16 __attribute__((ext_vector_type(16)));
typedef short bf16x8 __attribute__((ext_vector_type(8)));
typedef short bf16x4 __attribute__((ext_vector_type(4)));

constexpr int NB = 4, T = 8192, M = NB * T, D = 1024, DIN = 5640, NP = 5632, FF = 4096, PLE = 256;
constexpr float EPS = 1e-6f;
constexpr size_t MiB = 1u << 20;
constexpr size_t SEG = (size_t)M * 512;
constexpr size_t WS_CTL = 0;
constexpr size_t WS_BAR = 768 * 1024;
constexpr size_t WS_GB = 1 * MiB;
constexpr size_t WS_WIN = 2 * MiB, WS_WOA = 13 * MiB, WS_WOB = 14 * MiB, WS_WOUT = 15 * MiB, WS_WUP = 17 * MiB, WS_WDN = 25 * MiB, WS_WPG = 33 * MiB, WS_WPLE = 35 * MiB;
constexpr size_t WS_PBF = 36 * MiB;
constexpr size_t WS_XN = 52 * MiB;
constexpr size_t WS_SEG = 116 * MiB;
constexpr size_t WS_END = WS_SEG + 11 * 32 * MiB;
constexpr size_t DO_U = 0, DO_W = 32 * MiB, DO_A = 64 * MiB, DO_VT = 80 * MiB;

constexpr int LDS_MISC = 131072, LDS_BYTES = 131072 + 1024;
constexpr int NQ_GDN = 16, NQ_ATT = 1024;

__device__ __forceinline__ unsigned f2bf(float f) { unsigned u = __builtin_bit_cast(unsigned, f); return (u + 0x7fffu + ((u >> 16) & 1u)) >> 16; }
typedef float f32x2_t __attribute__((ext_vector_type(2))); typedef __bf16 bf16x2_t __attribute__((ext_vector_type(2)));
__device__ __forceinline__ unsigned pk2(float lo, float hi) { f32x2_t v = {lo, hi}; bf16x2_t b = __builtin_convertvector(v, bf16x2_t); return __builtin_bit_cast(unsigned, b); }
__device__ __forceinline__ float bf2f(unsigned short b) { return __uint_as_float((unsigned)b << 16); }
__device__ __forceinline__ float bflo(unsigned w) { return __uint_as_float(w << 16); }
__device__ __forceinline__ float bfhi(unsigned w) { return __uint_as_float(w & 0xffff0000u); }
__device__ __forceinline__ float wave_sum(float v);
__device__ __forceinline__ float silu(float x) { return x / (1.0f + __expf(-x)); }
__device__ __forceinline__ float dpp_xor1(float v) { return __builtin_bit_cast(float, __builtin_amdgcn_mov_dpp(__builtin_bit_cast(int, v), 0xB1, 0xF, 0xF, false)); }
__device__ __forceinline__ float dpp_xor2(float v) { return __builtin_bit_cast(float, __builtin_amdgcn_mov_dpp(__builtin_bit_cast(int, v), 0x4E, 0xF, 0xF, false)); }
__device__ __forceinline__ float dpp_hmirror(float v) { return __builtin_bit_cast(float, __builtin_amdgcn_mov_dpp(__builtin_bit_cast(int, v), 0x141, 0xF, 0xF, false)); }
__device__ __forceinline__ float dpp_ror4(float v) { return __builtin_bit_cast(float, __builtin_amdgcn_mov_dpp(__builtin_bit_cast(int, v), 0x124, 0xF, 0xF, false)); }
__device__ __forceinline__ float dpp_ror8(float v) { return __builtin_bit_cast(float, __builtin_amdgcn_mov_dpp(__builtin_bit_cast(int, v), 0x128, 0xF, 0xF, false)); }
__device__ __forceinline__ float dpp_rmirror(float v) { return __builtin_bit_cast(float, __builtin_amdgcn_mov_dpp(__builtin_bit_cast(int, v), 0x140, 0xF, 0xF, false)); }
__device__ __forceinline__ float xrow_sum(float v) {
    const auto r16 = __builtin_amdgcn_permlane16_swap(__float_as_uint(v), __float_as_uint(v), false, false);
    const float a = __uint_as_float(r16[0]) + __uint_as_float(r16[1]);
    const auto r32 = __builtin_amdgcn_permlane32_swap(__float_as_uint(a), __float_as_uint(a), false, false);
    return __uint_as_float(r32[0]) + __uint_as_float(r32[1]);
}
__device__ __forceinline__ float wave_sum(float v) { v += dpp_xor1(v); v += dpp_xor2(v); v += dpp_ror4(v); v += dpp_ror8(v); return xrow_sum(v); }
#define LDS_WAIT() asm volatile("s_waitcnt lgkmcnt(0)" ::: "memory")
#define LBAR() asm volatile("s_waitcnt lgkmcnt(0)\n\ts_barrier" ::: "memory")

struct Args {
    const float* x; const float* p; const int* pos; const float* attn_norm; const float* w_in; const float* conv_w; const float* a_log; const float* dt_bias; const float* gdn_norm;
    const float* w_o_a; const float* q_norm; const float* k_norm; const float* lq1; const float* lk1; const float* lq2; const float* lk2; const float* diff_norm; const float* w_o_b;
    const float* w_out; const float* mlp_norm; const float* w_up; const float* w_down; const float* ple_norm; const float* w_ple_gate; const float* w_ple;
    float* out; unsigned char* ws;
};

__device__ __forceinline__ void transpose_item(const float* W, int ldw, int K, bf16* WT, int n0_dst, int n0_src, int k0, const float* ks, LAS float* scr, int lane) {
    f32x4 ld[8];
#pragma unroll
    for (int i = 0; i < 8; ++i) { const int kk = 8 * i + (lane >> 3); ld[i] = *(const f32x4*)(W + (size_t)(k0 + kk) * ldw + n0_src + 4 * (lane & 7)); }
#pragma unroll
    for (int i = 0; i < 8; ++i) { const int kk = 8 * i + (lane >> 3); f32x4 v = ld[i]; if (ks) v = v * ks[k0 + kk];
        LAS float* d = scr + kk * 33 + 4 * (lane & 7); d[0] = v.x; d[1] = v.y; d[2] = v.z; d[3] = v.w; }
    LDS_WAIT(); asm volatile("" ::: "memory");
    const int c = lane & 7;
#pragma unroll
    for (int j = 0; j < 4; ++j) { const int n = (lane >> 3) + 8 * j; const LAS float* s = scr + (8 * c) * 33 + n;
        v4u o; o.x = pk2(s[0 * 33], s[1 * 33]); o.y = pk2(s[2 * 33], s[3 * 33]); o.z = pk2(s[4 * 33], s[5 * 33]); o.w = pk2(s[6 * 33], s[7 * 33]);
        *(v4u*)(WT + (size_t)(n0_dst + n) * K + k0 + 8 * c) = o; }
    LDS_WAIT(); asm volatile("" ::: "memory");
}
__device__ __forceinline__ void tr_matrix(int r, const float* W, int ldw, int K, int N, bf16* WT, const float* ks, bool win, LAS float* scr, int lane) {
    const int nblk = N / 32, kb = r / nblk, nb = r % nblk, n0 = 32 * nb; const int n0s = (win && n0 >= 2048) ? n0 + 8 : n0;
    transpose_item(W, ldw, K, WT, n0, n0s, 64 * kb, ks, scr, lane);
}
__device__ __forceinline__ void p0_prologue(const Args& A, unsigned char* lds_g) {
    LAS unsigned char* lds = (LAS unsigned char*)lds_g;
    int tid_ = threadIdx.x; asm volatile("" : "+v"(tid_)); const int tid = tid_, lane = tid & 63, wave = __builtin_amdgcn_readfirstlane(tid >> 6);
    unsigned char* ws = A.ws;
    LAS float* scr = (LAS float*)(lds + wave * 8448);
    LAS float* Wab = (LAS float*)(lds + 8 * 8448);
    for (int e = tid; e < 8192; e += 512) Wab[(e & 7) * 1024 + (e >> 3)] = A.w_in[(size_t)(e >> 3) * DIN + 2048 + (e & 7)];
    __syncthreads();
    const int gw = blockIdx.x * 8 + wave, NGW = gridDim.x * 8;
    constexpr int I1 = 16 * 176, I2 = 8 * 32, I3 = I2, I4 = 16 * 32, I5 = 16 * 128, I6 = 64 * 32, I7 = 16 * 32, I8 = 4 * 32;
    constexpr int NITEMS = I1 + I2 + I3 + I4 + I5 + I6 + I7 + I8;
    for (int it = gw; it < NITEMS; it += NGW) {
        int r = it;
        if (r < I1) { tr_matrix(r, A.w_in, DIN, D, NP, (bf16*)(ws + WS_WIN), nullptr, true, scr, lane); continue; } r -= I1;
        if (r < I2) { tr_matrix(r, A.w_o_a, D, 512, D, (bf16*)(ws + WS_WOA), nullptr, false, scr, lane); continue; } r -= I2;
        if (r < I3) { tr_matrix(r, A.w_o_b, D, 512, D, (bf16*)(ws + WS_WOB), nullptr, false, scr, lane); continue; } r -= I3;
        if (r < I4) { tr_matrix(r, A.w_out, D, D, D, (bf16*)(ws + WS_WOUT), nullptr, false, scr, lane); continue; } r -= I4;
        if (r < I5) { tr_matrix(r, A.w_up, FF, D, FF, (bf16*)(ws + WS_WUP), A.mlp_norm, false, scr, lane); continue; } r -= I5;
        if (r < I6) { tr_matrix(r, A.w_down, D, FF, D, (bf16*)(ws + WS_WDN), nullptr, false, scr, lane); continue; } r -= I6;
        if (r < I7) { tr_matrix(r, A.w_ple_gate, D, D, D, (bf16*)(ws + WS_WPG), A.ple_norm, false, scr, lane); continue; } r -= I7;
        tr_matrix(r, A.w_ple, D, PLE, D, (bf16*)(ws + WS_WPLE), nullptr, false, scr, lane);
    }
    bf16* XN = (bf16*)(ws + WS_XN); bf16* PB = (bf16*)(ws + WS_PBF);
    float* gbuf = (float*)(ws + WS_GB); float* bbuf = gbuf + (size_t)M * 4;
    f32x4 gn[4];
#pragma unroll
    for (int j = 0; j < 4; ++j) gn[j] = ((const f32x4*)A.attn_norm)[lane + 64 * j];
    f32x4 n1[4], n2[4], pn1, pn2;
    { const f32x4* xr = (const f32x4*)(A.x + (size_t)gw * D) + lane;
#pragma unroll
      for (int j = 0; j < 4; ++j) n1[j] = xr[64 * j];
      pn1 = ((const f32x4*)(A.p + (size_t)gw * PLE))[lane];
      const int m2 = (gw + NGW < M) ? gw + NGW : gw; const f32x4* xr2 = (const f32x4*)(A.x + (size_t)m2 * D) + lane;
#pragma unroll
      for (int j = 0; j < 4; ++j) n2[j] = xr2[64 * j];
      pn2 = ((const f32x4*)(A.p + (size_t)m2 * PLE))[lane]; }
    for (int m = gw; m < M; m += NGW) {
        {
        f32x4 vc[4]; const f32x4 pvc = pn1;
#pragma unroll
        for (int j = 0; j < 4; ++j) { vc[j] = n1[j]; n1[j] = n2[j]; }
        pn1 = pn2;
        { const int m3 = (m + 2 * NGW < M) ? m + 2 * NGW : m; const f32x4* xr3 = (const f32x4*)(A.x + (size_t)m3 * D) + lane;
#pragma unroll
          for (int j = 0; j < 4; ++j) n2[j] = xr3[64 * j];
          pn2 = ((const f32x4*)(A.p + (size_t)m3 * PLE))[lane]; }
        f32x4 v[4]; float s = 0.f;
#pragma unroll
        for (int j = 0; j < 4; ++j) { v[j] = vc[j]; s += (v[j].x * v[j].x + v[j].y * v[j].y) + (v[j].z * v[j].z + v[j].w * v[j].w); }
        const float rstd = rsqrtf(wave_sum(s) * (1.f / D) + EPS);
        float ab[8];
#pragma unroll
        for (int c = 0; c < 8; ++c) ab[c] = 0.f;
        unsigned long long* o8 = (unsigned long long*)(XN + (size_t)m * D) + lane;
#pragma unroll
        for (int j = 0; j < 4; ++j) { v[j] = v[j] * rstd * gn[j];
            o8[64 * j] = (unsigned long long)pk2(v[j].x, v[j].y) | ((unsigned long long)pk2(v[j].z, v[j].w) << 32);
#pragma unroll
            for (int c = 0; c < 8; ++c) { const f32x4 w4 = *(const LAS f32x4*)(Wab + c * 1024 + 256 * j + 4 * lane);
                ab[c] += (v[j].x * w4.x + v[j].y * w4.y) + (v[j].z * w4.z + v[j].w * w4.w); } }
        {
            const bool b0 = lane & 1, b1 = lane & 2, b2 = lane & 4;
            float w4[4], w2[2];
#pragma unroll
            for (int j = 0; j < 4; ++j) { const float send = b2 ? ab[j] : ab[j + 4], keep = b2 ? ab[j + 4] : ab[j]; w4[j] = keep + dpp_hmirror(send); }
#pragma unroll
            for (int j = 0; j < 2; ++j) { const float send = b1 ? w4[j] : w4[j + 2], keep = b1 ? w4[j + 2] : w4[j]; w2[j] = keep + dpp_xor2(send); }
            float tot; { const float send = b0 ? w2[0] : w2[1], keep = b0 ? w2[1] : w2[0]; tot = keep + dpp_xor1(send); }
            tot += dpp_ror8(tot); tot = xrow_sum(tot);
            const float partner = dpp_ror4(tot);
            if (lane < 4) { const int hd = lane;
                const float xx = tot + A.dt_bias[hd]; const float sp = xx > 20.f ? xx : log1pf(expf(xx));
                gbuf[(size_t)m * 4 + hd] = -expf(A.a_log[hd]) * sp;
                bbuf[(size_t)m * 4 + hd] = 1.0f / (1.0f + expf(-partner));
            }
        }
        const f32x4 pv = pvc;
        ((unsigned long long*)(PB + (size_t)m * PLE))[lane] = (unsigned long long)pk2(pv.x, pv.y) | ((unsigned long long)pk2(pv.z, pv.w) << 32);
        }
    }
}

__device__ __forceinline__ f32x4 mfma16(bf16x8 a, bf16x8 b, f32x4 c) { return __builtin_amdgcn_mfma_f32_16x16x32_bf16(a, b, c, 0, 0, 0); }
__device__ __forceinline__ f32x16 mfma32(bf16x8 a, bf16x8 b, f32x16 c) { return __builtin_amdgcn_mfma_f32_32x32x16_bf16(a, b, c, 0, 0, 0); }

template <int I> struct SolveRow {
    static __device__ __forceinline__ void run(float (&Tc)[64], const LAS float* Lf, int vz, float lanef) {
        SolveRow<I - 1>::run(Tc, Lf, vz, lanef);
        float a0 = fmaxf(1.0f - fabsf(lanef - (float)I), 0.0f), a1 = 0.f;
#pragma unroll
        for (int jj = 0; jj < (I + 3) / 4; ++jj) {
            const f32x4 l4 = *(const LAS f32x4*)(Lf + vz + I * 68 + 4 * jj);
            if (4 * jj + 0 < I) a0 -= l4.x * Tc[4 * jj + 0];
            if (4 * jj + 1 < I) a1 -= l4.y * Tc[4 * jj + 1];
            if (4 * jj + 2 < I) a0 -= l4.z * Tc[4 * jj + 2];
            if (4 * jj + 3 < I) a1 -= l4.w * Tc[4 * jj + 3];
        }
        Tc[I] = a0 + a1;
    }
};
template <> struct SolveRow<-1> { static __device__ __forceinline__ void run(float (&)[64], const LAS float*, int, float) {} };

#define GDN_LOAD_RAW(RAW_, CW_, GB_, unit_) do { const int bh_ = (unit_) >> 7, n_ = (unit_) & 127, b_ = bh_ >> 2, h_ = bh_ & 3; const size_t mm0 = (size_t)b_ * T + (size_t)n_ * 64; \
        const int ch_ = threadIdx.x & 127, tl0_ = 16 * (threadIdx.x >> 7), tseq_ = n_ * 64 + tl0_; \
        _Pragma("unroll") for (int s_ = 0; s_ < 3; ++s_) { const bf16* src_ = (const bf16*)(A.ws + WS_SEG) + (size_t)s_ * SEG + h_ * 128 + ch_; \
            _Pragma("unroll") for (int i_ = 0; i_ < 19; ++i_) RAW_[s_][i_] = (tseq_ - 3 + i_ >= 0) ? src_[(mm0 + tl0_ + i_ - 3) * 512] : (bf16)0; \
            _Pragma("unroll") for (int j_ = 0; j_ < 4; ++j_) CW_[s_][j_] = A.conv_w[j_ * 1536 + s_ * 512 + h_ * 128 + ch_]; } \
        GB_[0] = ((const float*)(A.ws + WS_GB))[(mm0 + (threadIdx.x & 63)) * 4 + h_]; GB_[1] = ((const float*)(A.ws + WS_GB) + (size_t)M * 4)[(mm0 + (threadIdx.x & 63)) * 4 + h_]; } while (0)
__device__ __forceinline__ void gdn_pre_unit(const Args& A, unsigned char* lds_g, int unit, bf16 (&raw)[3][19], float (&cw)[3][4], float (&gb)[2], int unit_next) {
    LAS unsigned char* lds = (LAS unsigned char*)lds_g;
    int tid_ = threadIdx.x; asm volatile("" : "+v"(tid_)); const int tid = tid_, lane = tid & 63, wave = __builtin_amdgcn_readfirstlane(tid >> 6);
    unsigned char* ws = A.ws;
    const int bh = unit >> 7, n = unit & 127, b = bh >> 2, h = bh & 3;
    const size_t m0 = (size_t)b * T + (size_t)n * 64;
    LAS bf16* Qb = (LAS bf16*)(lds);
    LAS bf16* Kb = (LAS bf16*)(lds + 17408);
    LAS bf16* VbT = (LAS bf16*)(lds + 34816);
    LAS bf16* KgT = (LAS bf16*)(lds + 53248);
    LAS float* Lf = (LAS float*)(lds + 71680);
    LAS bf16* Tb = (LAS bf16*)(lds + 89088);
    LAS float* Gs = (LAS float*)(lds + 98304);
    LAS float* Bs = Gs + 64; LAS float* SSQ = Gs + 128; LAS float* SSK = Gs + 192;
    const float* gbuf = (const float*)(ws + WS_GB); const float* bbuf = gbuf + (size_t)M * 4;
    const bf16* SG = (const bf16*)(ws + WS_SEG);
    bf16* qd = (bf16*)(ws + WS_XN) + (size_t)unit * 8192; bf16* kdT = (bf16*)(ws + WS_XN + 32 * MiB) + (size_t)unit * 8192;
    bf16* ub = (bf16*)((unsigned char*)A.out + DO_U) + (size_t)unit * 8192; bf16* wb = (bf16*)((unsigned char*)A.out + DO_W) + (size_t)unit * 8192;
    bf16* ab = (bf16*)((unsigned char*)A.out + DO_A) + (size_t)unit * 4096;
    float* egl = (float*)(ws + WS_CTL + 524288);
    if (wave == 0) {
        float gv = gb[0];
#pragma unroll
        for (int o = 1; o < 64; o <<= 1) { const float y = __shfl_up(gv, o); if (lane >= o) gv += y; }
        Gs[lane] = gv; Bs[lane] = gb[1]; SSQ[lane] = 0.f; SSK[lane] = 0.f;
        if (lane == 63) egl[(size_t)unit * 32] = __expf(gv);
    }
    LBAR();
    const int ch = tid & 127, tg = tid >> 7;
    float y[3][16];
#pragma unroll
    for (int s = 0; s < 3; ++s) {
        const int cidx = s * 512 + h * 128 + ch;
        const float w0 = cw[s][0], w1 = cw[s][1], w2 = cw[s][2], w3 = cw[s][3];
        float a0 = bf2f(raw[s][0]), a1 = bf2f(raw[s][1]), a2 = bf2f(raw[s][2]);
#pragma unroll
        for (int i = 0; i < 16; ++i) { const float a3 = bf2f(raw[s][3 + i]); y[s][i] = silu(w0 * a0 + w1 * a1 + w2 * a2 + w3 * a3); a0 = a1; a1 = a2; a2 = a3; }
    }
    if (unit_next < 2048) GDN_LOAD_RAW(raw, cw, gb, unit_next);
    {
        const bool b0 = lane & 1, b1 = lane & 2, b2 = lane & 4, b3 = lane & 8;
        float tot[2];
#pragma unroll
        for (int st = 0; st < 2; ++st) {
            float w8[8], w4[4], w2[2];
#pragma unroll
            for (int j = 0; j < 8; ++j) { const float lo = y[st][j] * y[st][j], hi = y[st][j + 8] * y[st][j + 8]; const float send = b3 ? lo : hi, keep = b3 ? hi : lo; w8[j] = keep + dpp_rmirror(send); }
#pragma unroll
            for (int j = 0; j < 4; ++j) { const float send = b2 ? w8[j] : w8[j + 4], keep = b2 ? w8[j + 4] : w8[j]; w4[j] = keep + dpp_hmirror(send); }
#pragma unroll
            for (int j = 0; j < 2; ++j) { const float send = b1 ? w4[j] : w4[j + 2], keep = b1 ? w4[j + 2] : w4[j]; w2[j] = keep + dpp_xor2(send); }
            { const float send = b0 ? w2[0] : w2[1], keep = b0 ? w2[1] : w2[0]; tot[st] = keep + dpp_xor1(send); }
            tot[st] = xrow_sum(tot[st]);
        }
        const int tok = lane & 15;
        if (lane < 16) { atomicAdd((float*)(SSQ + 16 * tg + tok), tot[0]); atomicAdd((float*)(SSK + 16 * tg + tok), tot[1]); }
    }
    LBAR();
    {
        const float g63 = Gs[63];
        unsigned vq[8], vk[8], vv[8], vd[8];
#pragma unroll
        for (int i = 0; i < 16; ++i) { const int tl = 16 * tg + i; const float rq = rsqrtf(SSQ[tl] + EPS), rk = rsqrtf(SSK[tl] + EPS), G = Gs[tl], be = Bs[tl], eG = __expf(G);
            const float qn = y[0][i] * rq, kn = y[1][i] * rk;
            Qb[tl * 136 + ch] = (bf16)f2bf(qn); Kb[tl * 136 + ch] = (bf16)f2bf(kn);
            const unsigned kg = f2bf(kn * be * eG), vb = f2bf(y[2][i] * be), kdv = f2bf(kn * __expf(g63 - G));
            if (i & 1) { vk[i >> 1] |= kg << 16; vv[i >> 1] |= vb << 16; vd[i >> 1] |= kdv << 16; } else { vk[i >> 1] = kg; vv[i >> 1] = vb; vd[i >> 1] = kdv; }
        }
        (void)vq;
        *(LAS v4u*)(KgT + ch * 72 + 16 * tg) = (v4u){vk[0], vk[1], vk[2], vk[3]}; *(LAS v4u*)(KgT + ch * 72 + 16 * tg + 8) = (v4u){vk[4], vk[5], vk[6], vk[7]};
        *(LAS v4u*)(VbT + ch * 72 + 16 * tg) = (v4u){vv[0], vv[1], vv[2], vv[3]}; *(LAS v4u*)(VbT + ch * 72 + 16 * tg + 8) = (v4u){vv[4], vv[5], vv[6], vv[7]};
        { const int blk = ch >> 4, rr_ = ch & 15, ks_ = tg >> 1, g0 = (2 * tg) & 3;
          *(v4u*)(kdT + (((blk * 2 + ks_) * 64 + g0 * 16 + rr_) << 3)) = (v4u){vd[0], vd[1], vd[2], vd[3]};
          *(v4u*)(kdT + (((blk * 2 + ks_) * 64 + (g0 + 1) * 16 + rr_) << 3)) = (v4u){vd[4], vd[5], vd[6], vd[7]}; }
    }
    LBAR();
    const int r = lane & 15, g = lane >> 4;
    {
#pragma unroll
        for (int pp = 0; pp < 2; ++pp) { const int p = tid + 512 * pp, frb = p >> 8, fks = (p >> 6) & 3, fl = p & 63, trow = 16 * frb + (fl & 15);
            const v4u qv = *(const LAS v4u*)(Qb + trow * 136 + 32 * fks + 8 * (fl >> 4)); const float sc = 0.08838834764831845f * __expf(Gs[trow]);
            v4u o; o.x = pk2(bflo(qv.x) * sc, bfhi(qv.x) * sc); o.y = pk2(bflo(qv.y) * sc, bfhi(qv.y) * sc); o.z = pk2(bflo(qv.z) * sc, bfhi(qv.z) * sc); o.w = pk2(bflo(qv.w) * sc, bfhi(qv.w) * sc);
            *(v4u*)(qd + ((size_t)p << 3)) = o; }
    }
    LAS bf16* Abuf = (LAS bf16*)(lds + 99328);
    {
        const int rb = wave & 3, which = wave >> 2;
        const LAS bf16* srcA = which ? Qb : Kb;
        bf16x8 af[4];
#pragma unroll
        for (int ks = 0; ks < 4; ++ks) af[ks] = *(const LAS bf16x8*)(srcA + (16 * rb + r) * 136 + 32 * ks + 8 * g);
#pragma unroll
        for (int cb = 0; cb < 4; ++cb) { f32x4 acc = {0.f, 0.f, 0.f, 0.f};
#pragma unroll
            for (int ks = 0; ks < 4; ++ks) { const bf16x8 bfr = *(const LAS bf16x8*)(Kb + (16 * cb + r) * 136 + 32 * ks + 8 * g); acc = mfma16(af[ks], bfr, acc); }
            const int s = 16 * cb + r; const float Gsv = Gs[s];
#pragma unroll
            for (int i = 0; i < 4; ++i) { const int c = 16 * rb + 4 * g + i; const float Gc = Gs[c];
                if (which == 0) { const float val = (s < c) ? Bs[c] * acc[i] * __expf(Gc - Gsv) : 0.f; Lf[c * 68 + s] = val; }
                else { const float val = (s <= c) ? 0.08838834764831845f * acc[i] * __expf(Gc - Gsv) : 0.f; Abuf[c * 72 + s] = (bf16)f2bf(val); } }
        }
    }
    LBAR();
    if (wave >= 4) {
#pragma unroll
        for (int pp = 0; pp < 2; ++pp) { const int p = (tid - 256) + 256 * pp, frb = p >> 7, fks = (p >> 6) & 1, fl = p & 63;
            *(v4u*)(ab + ((size_t)p << 3)) = *(const LAS v4u*)(Abuf + (16 * frb + (fl & 15)) * 72 + 32 * fks + 8 * (fl >> 4)); }
    }
    if (wave == 0) {
        float Tc[64]; int vz = 0; asm volatile("" : "+v"(vz));
        SolveRow<63>::run(Tc, Lf, vz, (float)lane);
#pragma unroll
        for (int i = 0; i < 64; ++i) Tb[i * 72 + lane] = (bf16)f2bf(Tc[i]);
    }
    LBAR();
    {
        const int rb = wave & 3, which = wave >> 2;
        const LAS bf16* srcB = which ? KgT : VbT; bf16* dst = which ? wb : ub;
        bf16x8 af[2];
#pragma unroll
        for (int ks = 0; ks < 2; ++ks) af[ks] = *(const LAS bf16x8*)(Tb + (16 * rb + r) * 72 + 32 * ks + 8 * g);
#pragma unroll
        for (int cb = 0; cb < 8; ++cb) { f32x4 acc = {0.f, 0.f, 0.f, 0.f};
#pragma unroll
            for (int ks = 0; ks < 2; ++ks) { const bf16x8 bfr = *(const LAS bf16x8*)(srcB + (16 * cb + r) * 72 + 32 * ks + 8 * g); acc = mfma16(af[ks], bfr, acc); }
            if (which == 0) { *(v2u*)(dst + (((rb * 8 + cb) * 64 + lane) << 2)) = (v2u){pk2(acc[0], acc[1]), pk2(acc[2], acc[3])}; }
            else {
#pragma unroll
            for (int i = 0; i < 4; ++i) { const int c_ = 16 * rb + 4 * g + i, k_ = 16 * cb + r;
                Qb[c_ * 136 + k_] = (bf16)f2bf(acc[i]); } }
        }
    }
    LBAR();
    {
#pragma unroll
        for (int pp = 0; pp < 2; ++pp) { const int p = tid + 512 * pp, frb = p >> 8, fks = (p >> 6) & 3, fl = p & 63;
            *(v4u*)(wb + ((size_t)p << 3)) = *(const LAS v4u*)(Qb + (16 * frb + (fl & 15)) * 136 + 32 * fks + 8 * (fl >> 4)); }
    }
    LBAR();
}

__device__ __forceinline__ void diff_prep_unit(const Args& A, unsigned char* lds_g, int mt) {
    LAS unsigned char* lds = (LAS unsigned char*)lds_g;
    int tid_ = threadIdx.x; asm volatile("" : "+v"(tid_)); const int tid = tid_, lane = tid & 63, wave = __builtin_amdgcn_readfirstlane(tid >> 6);
    unsigned char* ws = A.ws;
    bf16* SG = (bf16*)(ws + WS_SEG);
    const size_t m0 = (size_t)mt * 64;
    const float invf[8] = {1.0f, 0.1939227432012558f, 0.03760603070259094f, 0.007292664609849453f, 0.0014142135623842478f, 0.00027424818836152554f, 5.3182957344688475e-05f, 1.0313385246263351e-05f};
    const int dl = (lane & 7) * 8;
    float gq[8], gk[8];
#pragma unroll
    for (int e = 0; e < 8; ++e) { gq[e] = A.q_norm[dl + e]; gk[e] = A.k_norm[dl + e]; }
    v4u rawv[8][2]; int posv[8];
#pragma unroll
    for (int rr = 0; rr < 8; ++rr) { const size_t m = m0 + wave * 8 + rr; posv[rr] = A.pos[m];
        rawv[rr][0] = *(const v4u*)(SG + (size_t)4 * SEG + m * 512 + 8 * lane); rawv[rr][1] = *(const v4u*)(SG + (size_t)5 * SEG + m * 512 + 8 * lane); }
#pragma unroll
    for (int rr = 0; rr < 8; ++rr) {
        const size_t m = m0 + wave * 8 + rr;
        const float posf = (float)posv[rr];
        float cs[8], sn[8];
#pragma unroll
        for (int e = 0; e < 8; ++e) { const float ang = posf * invf[e]; const double ad = (double)ang; const double nn = __builtin_rint(ad * 0.15915494309189535); const float rr2 = (float)(ad - nn * 6.283185307179586);
            cs[e] = __cosf(rr2); sn[e] = __sinf(rr2); }
#pragma unroll
        for (int arr = 0; arr < 2; ++arr) {
            bf16* ptr = SG + (size_t)(4 + arr) * SEG + m * 512 + 8 * lane;
            const v4u raw = rawv[rr][arr];
            float v[8] = {bflo(raw.x), bfhi(raw.x), bflo(raw.y), bfhi(raw.y), bflo(raw.z), bfhi(raw.z), bflo(raw.w), bfhi(raw.w)};
            float ss = 0.f;
#pragma unroll
            for (int e = 0; e < 8; ++e) ss += v[e] * v[e];
            ss += dpp_xor1(ss); ss += dpp_xor2(ss); ss += dpp_hmirror(ss);
            const float rstd = rsqrtf(ss * (1.0f / 64.0f) + EPS);
#pragma unroll
            for (int e = 0; e < 8; ++e) v[e] = v[e] * rstd * (arr ? gk[e] : gq[e]);
            const int l7 = lane & 7;
#pragma unroll
            for (int e = 0; e < 8; ++e) { const float other = dpp_xor1(v[e]);
                if (l7 == 0) v[e] = v[e] * cs[e] - other * sn[e]; else if (l7 == 1) v[e] = v[e] * cs[e] + other * sn[e]; }
            const float sc = arr ? 1.0f : 0.125f * 1.4426950408889634f;
            v4u o; o.x = pk2(v[0] * sc, v[1] * sc); o.y = pk2(v[2] * sc, v[3] * sc); o.z = pk2(v[4] * sc, v[5] * sc); o.w = pk2(v[6] * sc, v[7] * sc);
            *(v4u*)ptr = o;
        }
    }
    LAS bf16* tile = (LAS bf16*)lds;
    const bf16* vsrc = SG + (size_t)6 * SEG + m0 * 512;
#pragma unroll
    for (int i = 0; i < 8; ++i) { const int id = tid + 512 * i, row = id >> 6, c16 = id & 63; *(LAS v4u*)(tile + row * 520 + c16 * 8) = *(const v4u*)(vsrc + (size_t)row * 512 + c16 * 8); }
    __syncthreads();
    {
        const int b = (int)(m0 / T), tt = (int)((m0 % T) / 64), hh = tid >> 7, d = tid & 127;
        bf16* dst = (bf16*)((unsigned char*)A.out + DO_VT) + (((size_t)(b * 4 + hh) * 128 + tt) * 128 + d) * 64;
#pragma unroll
        for (int c8 = 0; c8 < 8; ++c8) { unsigned w[4];
#pragma unroll
            for (int e = 0; e < 4; ++e) { const int q2 = 2 * e, kv = 16 * (c8 >> 1) + 8 * (q2 >> 2) + 4 * (c8 & 1) + (q2 & 3);
                const unsigned lo = tile[kv * 520 + tid], hi = tile[(kv + 1) * 520 + tid]; w[e] = lo | (hi << 16); }
            *(v4u*)(dst + c8 * 8) = (v4u){w[0], w[1], w[2], w[3]}; }
    }
    __syncthreads();
}

__device__ __forceinline__ void gdn_scan_item(const Args& A, unsigned char* lds_g, int bh) {
    LAS unsigned char* lds = (LAS unsigned char*)lds_g;
    int tid_ = threadIdx.x; asm volatile("" : "+v"(tid_)); const int tid = tid_, lane = tid & 63, wave = __builtin_amdgcn_readfirstlane(tid >> 6);
    unsigned char* ws = A.ws;
    const int r = lane & 15, g = lane >> 4, sl = wave, b = bh >> 2, h = bh & 3;
    LAS bf16* H1 = (LAS bf16*)lds;
    LAS bf16* H2 = (LAS bf16*)(lds + 32768);
    LAS bf16* ST = (LAS bf16*)(lds + 57344) + wave * 3328;
    LAS bf16* VN = ST + 2176;
    const v4u* qd4 = (const v4u*)((const bf16*)(ws + WS_XN) + (size_t)bh * 128 * 8192); const v4u* kd4 = (const v4u*)((const bf16*)(ws + WS_XN + 32 * MiB) + (size_t)bh * 128 * 8192);
    const v4u* wb4 = (const v4u*)((const bf16*)((unsigned char*)A.out + DO_W) + (size_t)bh * 128 * 8192); const v4u* ab4 = (const v4u*)((const bf16*)((unsigned char*)A.out + DO_A) + (size_t)bh * 128 * 4096);
    const bf16* ub = (const bf16*)((unsigned char*)A.out + DO_U) + (size_t)bh * 128 * 8192;
    const float* egl = (const float*)(ws + WS_CTL + 524288) + (size_t)bh * 128 * 32;
    float* oraw = (float*)(ws + WS_SEG) + ((size_t)b * T) * 512 + h * 128 + 16 * sl + r;
    f32x4 S[8];
#pragma unroll
    for (int k = 0; k < 8; ++k) { S[k] = (f32x4){0.f, 0.f, 0.f, 0.f}; *(LAS v2u*)(ST + r * 136 + 16 * k + 4 * g) = (v2u){0u, 0u}; }
    v4u sA[7], sB[7];
#define SCAN_LOADOPS(S_, i_) do { const size_t o1 = (size_t)(i_) * 1024, o2 = (size_t)(i_) * 512; \
        S_[0] = wb4[o1 + tid]; S_[1] = wb4[o1 + tid + 512]; S_[2] = qd4[o1 + tid]; S_[3] = qd4[o1 + tid + 512]; \
        S_[4] = ab4[o2 + tid]; S_[5] = kd4[o1 + tid]; S_[6] = kd4[o1 + tid + 512]; } while (0)
#define SCAN_WRITE_H1(S_) do { LAS v4u* p_ = (LAS v4u*)H1; p_[tid] = S_[0]; p_[tid + 512] = S_[1]; p_[1024 + tid] = S_[2]; p_[1536 + tid] = S_[3]; } while (0)
#define SCAN_WRITE_H2(S_) do { LAS v4u* p_ = (LAS v4u*)H2; p_[tid] = S_[4]; p_[512 + tid] = S_[5]; p_[1024 + tid] = S_[6]; } while (0)
    SCAN_LOADOPS(sA, 0); SCAN_WRITE_H1(sA); SCAN_WRITE_H2(sA);
    SCAN_LOADOPS(sB, 1);
    v2u uC[4], uN[4]; float eg = egl[0], egN = eg;
#pragma unroll
    for (int rb = 0; rb < 4; ++rb) uC[rb] = *(const v2u*)(ub + (((rb * 8 + sl) * 64 + lane) << 2));
    __syncthreads();
#define SCAN_STEP(i_, SNEXT_, SLOAD_) do { \
        if ((i_) + 2 < 128) SCAN_LOADOPS(SLOAD_, (i_) + 2); \
        { const int in_ = ((i_) + 1 < 128) ? (i_) + 1 : 127; \
          _Pragma("unroll") for (int rb = 0; rb < 4; ++rb) uN[rb] = *(const v2u*)(ub + (size_t)in_ * 8192 + (((rb * 8 + sl) * 64 + lane) << 2)); \
          egN = egl[(size_t)in_ * 32]; } \
        bf16x8 sb[4]; \
        _Pragma("unroll") for (int ks = 0; ks < 4; ++ks) sb[ks] = *(const LAS bf16x8*)(ST + r * 136 + 32 * ks + 8 * g); \
        f32x4 acc2[4]; \
        _Pragma("unroll") for (int rb = 0; rb < 4; ++rb) { \
            f32x4 acc1 = {0.f, 0.f, 0.f, 0.f}; acc2[rb] = (f32x4){0.f, 0.f, 0.f, 0.f}; \
            _Pragma("unroll") for (int ks = 0; ks < 4; ++ks) { \
                const bf16x8 wf = *(const LAS bf16x8*)(H1 + (((rb * 4 + ks) * 64 + lane) << 3)), qf = *(const LAS bf16x8*)(H1 + 8192 + (((rb * 4 + ks) * 64 + lane) << 3)); \
                acc1 = mfma16(wf, sb[ks], acc1); acc2[rb] = mfma16(qf, sb[ks], acc2[rb]); } \
            const float v0 = bflo(uC[rb].x) - acc1[0], v1 = bfhi(uC[rb].x) - acc1[1], v2 = bflo(uC[rb].y) - acc1[2], v3 = bfhi(uC[rb].y) - acc1[3]; \
            *(LAS v2u*)(VN + r * 72 + 16 * rb + 4 * g) = (v2u){pk2(v0, v1), pk2(v2, v3)}; } \
        LBAR(); \
        if ((i_) + 1 < 128) SCAN_WRITE_H1(SNEXT_); \
        bf16x8 vb[2]; \
        _Pragma("unroll") for (int ks = 0; ks < 2; ++ks) vb[ks] = *(const LAS bf16x8*)(VN + r * 72 + 32 * ks + 8 * g); \
        _Pragma("unroll") for (int rb = 0; rb < 4; ++rb) { \
            _Pragma("unroll") for (int ks = 0; ks < 2; ++ks) { const bf16x8 af = *(const LAS bf16x8*)(H2 + (((rb * 2 + ks) * 64 + lane) << 3)); acc2[rb] = mfma16(af, vb[ks], acc2[rb]); } \
            float* op = oraw + ((size_t)(i_) * 64 + 16 * rb + 4 * g) * 512; \
            op[0] = acc2[rb][0]; op[512] = acc2[rb][1]; op[1024] = acc2[rb][2]; op[1536] = acc2[rb][3]; } \
        _Pragma("unroll") for (int k = 0; k < 8; ++k) { S[k] = S[k] * eg; \
            _Pragma("unroll") for (int ks = 0; ks < 2; ++ks) { const bf16x8 kf = *(const LAS bf16x8*)(H2 + 4096 + (((k * 2 + ks) * 64 + lane) << 3)); S[k] = mfma16(kf, vb[ks], S[k]); } \
            *(LAS v2u*)(ST + r * 136 + 16 * k + 4 * g) = (v2u){pk2(S[k][0], S[k][1]), pk2(S[k][2], S[k][3])}; } \
        LBAR(); \
        if ((i_) + 1 < 128) SCAN_WRITE_H2(SNEXT_); \
        _Pragma("unroll") for (int rb = 0; rb < 4; ++rb) uC[rb] = uN[rb]; \
        eg = egN; \
    } while (0)
    for (int i = 0; i < 128; i += 2) { SCAN_STEP(i, sB, sA); SCAN_STEP(i + 1, sA, sB); }
    __syncthreads();
#undef SCAN_STEP
#undef SCAN_LOADOPS
#undef SCAN_WRITE_H1
#undef SCAN_WRITE_H2
}

__device__ __forceinline__ void attn_unit(const Args& A, unsigned char* lds_g, int bh, int qb, float negshift, float lam) {
    LAS unsigned char* lds = (LAS unsigned char*)lds_g;
    int tid_ = threadIdx.x; asm volatile("" : "+v"(tid_)); const int tid = tid_, lane = tid & 63, wave = __builtin_amdgcn_readfirstlane(tid >> 6);
    unsigned char* ws = A.ws;
    const int r = lane & 31, hh = lane >> 5, comp = wave >> 2, w4 = wave & 3;
    const int b = bh >> 2, h = bh & 3;
    const size_t rowbase = (size_t)b * T; const int q0 = qb * 128;
    const bf16* DQ = (const bf16*)(ws + WS_SEG) + (size_t)4 * SEG; const bf16* DK = (const bf16*)(ws + WS_SEG) + (size_t)5 * SEG;
    const bf16* VT = (const bf16*)((unsigned char*)A.out + DO_VT) + (size_t)bh * 128 * 8192;
    bf16* OB = (bf16*)(ws + WS_SEG) + (size_t)6 * SEG;
    LAS bf16* Ks = (LAS bf16*)lds;
    LAS bf16* Vs = (LAS bf16*)(lds + 34816);
    LAS bf16* Qs = (LAS bf16*)(lds + 90112);
#pragma unroll
    for (int i = 0; i < 4; ++i) { const int id = tid + 512 * i, qrow = id >> 4, qch = id & 15;
        *(LAS v4u*)(Qs + qrow * 136 + qch * 8) = *(const v4u*)(DQ + (rowbase + q0 + qrow) * 512 + h * 128 + qch * 8); }
    const LAS bf16* qfp = Qs + (32 * w4 + r) * 136 + comp * 64 + 8 * hh;
    f32x16 o[4];
#pragma unroll
    for (int d = 0; d < 4; ++d)
#pragma unroll
        for (int i = 0; i < 16; ++i) o[d][i] = 0.f;
    float lsum = 0.f;
    const int nt = 2 * (qb + 1);
    const int id0 = tid, id1 = tid + 512;
    const bf16* ksrc0 = DK + (rowbase + (id0 >> 4)) * 512 + h * 128 + (id0 & 15) * 8; const bf16* ksrc1 = DK + (rowbase + (id1 >> 4)) * 512 + h * 128 + (id1 & 15) * 8;
    const int kdst0 = (id0 >> 4) * 136 + (id0 & 15) * 8, kdst1 = (id1 >> 4) * 136 + (id1 & 15) * 8;
    const int vdst0 = (id0 >> 3) * 72 + (id0 & 7) * 8, vdst1 = (id1 >> 3) * 72 + (id1 & 7) * 8;
    v4u kr0, kr1, vr0, vr1;
#define ATT_LOADK(S_, t_) do { kr0 = *(const v4u*)(ksrc0 + (size_t)(t_) * 64 * 512); kr1 = *(const v4u*)(ksrc1 + (size_t)(t_) * 64 * 512); } while (0)
#define ATT_LOADV(t_) do { vr0 = *(const v4u*)(VT + (size_t)(t_) * 8192 + id0 * 8); vr1 = *(const v4u*)(VT + (size_t)(t_) * 8192 + id1 * 8); } while (0)
#define ATT_WRITE(S_, kbuf_, voff_) do { LAS bf16* kb_ = Ks + (kbuf_) * (64 * 136); LAS bf16* vb_ = Vs + (voff_); \
        *(LAS v4u*)(kb_ + kdst0) = kr0; *(LAS v4u*)(kb_ + kdst1) = kr1; \
        *(LAS v4u*)(vb_ + vdst0) = vr0; *(LAS v4u*)(vb_ + vdst1) = vr1; } while (0)
    ATT_LOADK(A, 0); ATT_LOADV(0); ATT_WRITE(A, 0, 0);
    __syncthreads();
    const int qrel = 32 * w4 + r;
    constexpr int VSZ = 128 * 72;
    int vcur = 0, vprev = 2 * VSZ, vnext = VSZ;
    bf16x8 pbp[2][2];
#pragma unroll
    for (int a = 0; a < 2; ++a)
#pragma unroll
        for (int b2 = 0; b2 < 2; ++b2) pbp[a][b2] = (bf16x8){0, 0, 0, 0, 0, 0, 0, 0};
    for (int e = tid; e < VSZ / 8; e += 512) *(LAS v4u*)(Vs + 2 * VSZ + e * 8) = (v4u){0u, 0u, 0u, 0u};
    __syncthreads();
#define ATT_VFRAGP(d_, kb_, s_) (*(const LAS bf16x8*)(Vp + (32 * (d_) + r) * 72 + 32 * (kb_) + 16 * (s_) + 8 * hh))
#define ATT_EXP8(P_, S2_, KB_, BANDED, DST_) do { \
        _Pragma("unroll") for (int i = 8 * (S2_); i < 8 * (S2_) + 8; ++i) { float e = __builtin_amdgcn_exp2f(P_[i]); \
            if (BANDED) { const int kvrel = 64 * band + 32 * (KB_) + (i & 3) + 8 * (i >> 2) + 4 * hh; if (kvrel > qrel) e = 0.f; } \
            P_[i] = e; lsum += e; } \
        { v4u w; w.x = pk2(P_[8 * (S2_) + 0], P_[8 * (S2_) + 1]); w.y = pk2(P_[8 * (S2_) + 2], P_[8 * (S2_) + 3]); \
            w.z = pk2(P_[8 * (S2_) + 4], P_[8 * (S2_) + 5]); w.w = pk2(P_[8 * (S2_) + 6], P_[8 * (S2_) + 7]); DST_ = __builtin_bit_cast(bf16x8, w); } \
    } while (0)
#define ATT_TILE(BANDED, PAR_, LOADS_, WRITES_) do { \
        LOADS_; \
        const LAS bf16* Kb = Ks + (PAR_) * (64 * 136); const LAS bf16* Vp = Vs + vprev; \
        const int band = t - (nt - 2); \
        bf16x8 kf[2][4], qf[4]; \
        _Pragma("unroll") for (int kb = 0; kb < 2; ++kb) _Pragma("unroll") for (int ks = 0; ks < 4; ++ks) kf[kb][ks] = *(const LAS bf16x8*)(Kb + (32 * kb + r) * 136 + comp * 64 + 16 * ks + 8 * hh); \
        _Pragma("unroll") for (int ks = 0; ks < 4; ++ks) qf[ks] = *(const LAS bf16x8*)(qfp + 16 * ks); \
        __builtin_amdgcn_sched_barrier(0); \
        f32x16 p0, p1; \
        _Pragma("unroll") for (int i = 0; i < 16; ++i) { p0[i] = negshift; p1[i] = negshift; } \
        _Pragma("unroll") for (int ks = 0; ks < 4; ++ks) p0 = mfma32(kf[0][ks], qf[ks], p0); \
        _Pragma("unroll") for (int ks = 0; ks < 4; ++ks) p1 = mfma32(kf[1][ks], qf[ks], p1); \
        bf16x8 vfa[8]; \
        _Pragma("unroll") for (int d = 0; d < 4; ++d) _Pragma("unroll") for (int s2 = 0; s2 < 2; ++s2) vfa[d * 2 + s2] = ATT_VFRAGP(d, 0, s2); \
        __builtin_amdgcn_sched_barrier(0); \
        bf16x8 pbn[2][2]; \
          \
        _Pragma("unroll") for (int d = 0; d < 4; ++d) o[d] = mfma32(vfa[d * 2 + 0], pbp[0][0], o[d]); \
        ATT_EXP8(p0, 0, 0, BANDED, pbn[0][0]); \
        _Pragma("unroll") for (int d = 0; d < 4; ++d) o[d] = mfma32(vfa[d * 2 + 1], pbp[0][1], o[d]); \
        ATT_EXP8(p0, 1, 0, BANDED, pbn[0][1]); \
        bf16x8 vfb[8]; \
        _Pragma("unroll") for (int d = 0; d < 4; ++d) _Pragma("unroll") for (int s2 = 0; s2 < 2; ++s2) vfb[d * 2 + s2] = ATT_VFRAGP(d, 1, s2); \
        __builtin_amdgcn_sched_barrier(0); \
        _Pragma("unroll") for (int d = 0; d < 4; ++d) o[d] = mfma32(vfb[d * 2 + 0], pbp[1][0], o[d]); \
        ATT_EXP8(p1, 0, 1, BANDED, pbn[1][0]); \
        _Pragma("unroll") for (int d = 0; d < 4; ++d) o[d] = mfma32(vfb[d * 2 + 1], pbp[1][1], o[d]); \
        ATT_EXP8(p1, 1, 1, BANDED, pbn[1][1]); \
        __builtin_amdgcn_sched_barrier(0); \
        _Pragma("unroll") for (int a = 0; a < 2; ++a) _Pragma("unroll") for (int b2 = 0; b2 < 2; ++b2) pbp[a][b2] = pbn[a][b2]; \
        WRITES_; \
        { const int tmp = vprev; vprev = vcur; vcur = vnext; vnext = tmp; } \
        __syncthreads(); \
    } while (0)
    int t = 0;
    for (; t < nt - 2; t += 2) {
        ATT_TILE(false, 0, { ATT_LOADK(A, t + 1); ATT_LOADV(t + 1); }, ATT_WRITE(B, 1, vnext));
        ++t; ATT_TILE(false, 1, { ATT_LOADK(B, t + 1); ATT_LOADV(t + 1); }, ATT_WRITE(A, 0, vnext)); --t;
    }
    ATT_TILE(true, 0, { ATT_LOADK(A, t + 1); ATT_LOADV(t + 1); }, ATT_WRITE(B, 1, vnext)); ++t;
    ATT_TILE(true, 1, (void)0, (void)0);
    {
        const LAS bf16* Vp = Vs + vprev;
#pragma unroll
        for (int kb = 0; kb < 2; ++kb)
#pragma unroll
            for (int s2 = 0; s2 < 2; ++s2)
#pragma unroll
                for (int d = 0; d < 4; ++d) o[d] = mfma32(ATT_VFRAGP(d, kb, s2), pbp[kb][s2], o[d]);
    }
    __syncthreads();
#undef ATT_TILE
#undef ATT_EXP8
#undef ATT_VFRAGP
#undef ATT_LOADK
#undef ATT_LOADV
#undef ATT_WRITE
    lsum += __shfl_xor(lsum, 32);
    const float inv = 1.0f / lsum;
    LAS float* X = (LAS float*)lds;
    if (comp == 1) {
#pragma unroll
        for (int d = 0; d < 4; ++d)
#pragma unroll
            for (int i = 0; i < 16; ++i) X[(w4 * 64 + d * 16 + i) * 64 + lane] = o[d][i] * inv;
    }
    __syncthreads();
    if (comp == 0) {
        float ss = 0.f;
#pragma unroll
        for (int d = 0; d < 4; ++d)
#pragma unroll
            for (int i = 0; i < 16; ++i) { const float v = o[d][i] * inv - lam * X[(w4 * 64 + d * 16 + i) * 64 + lane]; o[d][i] = v; ss += v * v; }
        ss += __shfl_xor(ss, 32);
        const float rstd = rsqrtf(ss * (1.0f / 128.0f) + EPS) * 0.8f;
        bf16* orow = OB + (rowbase + q0 + 32 * w4 + r) * 512 + h * 128;
#pragma unroll
        for (int d = 0; d < 4; ++d)
#pragma unroll
            for (int g4 = 0; g4 < 4; ++g4) { const int dd = 32 * d + 8 * g4 + 4 * hh; const f32x4 gn = *(const f32x4*)(A.diff_norm + dd);
                v2u w; w.x = pk2(o[d][4 * g4 + 0] * rstd * gn.x, o[d][4 * g4 + 1] * rstd * gn.y); w.y = pk2(o[d][4 * g4 + 2] * rstd * gn.z, o[d][4 * g4 + 3] * rstd * gn.w);
                *(v2u*)(orow + dd) = w; }
    }
    __syncthreads();
}

__device__ __forceinline__ void p4_post(const Args& A) {
    int tid_ = threadIdx.x; asm volatile("" : "+v"(tid_)); const int tid = tid_, lane = tid & 63, wave = tid >> 6;
    unsigned char* ws = A.ws;
    const float* oraw = (const float*)(ws + WS_SEG); const bf16* Z = (const bf16*)(ws + WS_SEG) + (size_t)3 * SEG; bf16* OA = (bf16*)(ws + WS_SEG) + (size_t)2 * SEG;
    const int gw = blockIdx.x * 8 + wave, NGW = gridDim.x * 8;
    const int d0 = (lane & 15) * 8;
    float gn[8];
#pragma unroll
    for (int e = 0; e < 8; ++e) gn[e] = A.gdn_norm[d0 + e];
    for (int m0r = gw; m0r < M; m0r += 4 * NGW) {
        f32x4 a0v[4], a1v[4]; v4u zv[4];
#pragma unroll
        for (int q4 = 0; q4 < 4; ++q4) { const int m = m0r + q4 * NGW; a0v[q4] = *(const f32x4*)(oraw + (size_t)m * 512 + 8 * lane); a1v[q4] = *(const f32x4*)(oraw + (size_t)m * 512 + 8 * lane + 4); zv[q4] = *(const v4u*)(Z + (size_t)m * 512 + 8 * lane); }
#pragma unroll
        for (int q4 = 0; q4 < 4; ++q4) { const int m = m0r + q4 * NGW; const f32x4 a0 = a0v[q4], a1 = a1v[q4];
        float v[8] = {a0.x, a0.y, a0.z, a0.w, a1.x, a1.y, a1.z, a1.w};
        float ss = 0.f;
#pragma unroll
        for (int e = 0; e < 8; ++e) ss += v[e] * v[e];
        ss += dpp_xor1(ss); ss += dpp_xor2(ss); ss += dpp_hmirror(ss); ss += dpp_rmirror(ss);
        const float rstd = rsqrtf(ss * (1.0f / 128.0f) + EPS);
        const v4u zr = zv[q4];
        const float z[8] = {bflo(zr.x), bfhi(zr.x), bflo(zr.y), bfhi(zr.y), bflo(zr.z), bfhi(zr.z), bflo(zr.w), bfhi(zr.w)};
#pragma unroll
        for (int e = 0; e < 8; ++e) v[e] = v[e] * rstd * gn[e] * silu(z[e]);
        v4u o; o.x = pk2(v[0], v[1]); o.y = pk2(v[2], v[3]); o.z = pk2(v[4], v[5]); o.w = pk2(v[6], v[7]);
        *(v4u*)(OA + (size_t)m * 512 + 8 * lane) = o;
        }
    }
}

#define XB_TMO      128
#define XB_XCNT(j)  (256  + 64 * (j))
#define XB_XSUB(j)  (1280 + 64 * (j))
#define XB_XGEN(j)  (2304 + 64 * (j))
#define XB_TOP      3328
#define XB_TOPGEN   3392
#define XCD_BAR_WORDS 3456
#define XB_SPIN_CAP (1u << 18)

__device__ __forceinline__ unsigned xb_ld(unsigned* p)              { return __hip_atomic_load(p, __ATOMIC_RELAXED, __HIP_MEMORY_SCOPE_AGENT); }
__device__ __forceinline__ unsigned xb_add(unsigned* p, unsigned v) { return __hip_atomic_fetch_add(p, v, __ATOMIC_RELAXED, __HIP_MEMORY_SCOPE_AGENT); }
__device__ __forceinline__ unsigned xb_xcc_id() { return (unsigned)__builtin_amdgcn_s_getreg((3 << 11) | 20) & 0xFu; }
#define XB_SPIN(cond, bar) do { unsigned _sp = 0; while (cond) { __builtin_amdgcn_s_sleep(1); \
    if ((++_sp & 255u) == 0u) { if (xb_ld(&(bar)[XB_TMO])) break; if (_sp > XB_SPIN_CAP) { atomicAdd(&(bar)[XB_TMO], 1u); break; } } } } while (0)

struct XcdBarrier {
    unsigned* bar; unsigned x;
    volatile LAS unsigned* st;
};

__device__ __forceinline__ XcdBarrier xcd_barrier_post(unsigned* bar, volatile LAS unsigned* st) {
    XcdBarrier b; b.bar = bar; b.x = xb_xcc_id(); b.st = st;
    if (threadIdx.x == 0) (void)xb_add(&bar[XB_XCNT(b.x)], 1u);
    return b;
}
__device__ __forceinline__ void xcd_barrier_complete(unsigned* bar, unsigned x, unsigned& nloc, unsigned& nx) {
    const unsigned G = gridDim.x * gridDim.y * gridDim.z;
    unsigned sum, cnt, mine, sp = 0u;
    for (;;) {
        sum = 0u; cnt = 0u; mine = 0u;
#pragma unroll
        for (unsigned j = 0; j < 16; ++j) { const unsigned c = xb_ld(&bar[XB_XCNT(j)]); sum += c; cnt += (c > 0u) ? 1u : 0u; mine = (j == x) ? c : mine; }
        if (sum == G) break;
        __builtin_amdgcn_s_sleep(1);
        if ((++sp & 255u) == 0u) { if (xb_ld(&bar[XB_TMO])) break; if (sp > XB_SPIN_CAP) { atomicAdd(&bar[XB_TMO], 1u); break; } }
    }
    nloc = mine > 0u ? mine : 1u; nx = cnt > 0u ? cnt : 1u;
}

__device__ __forceinline__ void xcd_barrier(const XcdBarrier& b) {
    asm volatile("s_waitcnt vmcnt(0)" ::: "memory");
    __syncthreads();
    if (threadIdx.x == 0) {
        unsigned* bar = b.bar;
        __builtin_amdgcn_s_waitcnt(0);
        unsigned nloc = b.st[0], nx = b.st[1];
        if (nloc == 0u) { xcd_barrier_complete(bar, b.x, nloc, nx); b.st[0] = nloc; b.st[1] = nx; }
        const unsigned old = xb_add(&bar[XB_XSUB(b.x)], 1u);
        const unsigned gen = old / nloc;
        if (old + 1u == (gen + 1u) * nloc) {
            __builtin_amdgcn_fence(__ATOMIC_RELEASE, "agent");
            asm volatile("s_waitcnt vmcnt(0)" ::: "memory");
            const unsigned og = xb_add(&bar[XB_TOP], 1u);
            const unsigned tg = og / nx;
            if (og + 1u == (tg + 1u) * nx) xb_add(&bar[XB_TOPGEN], 1u);
            else XB_SPIN(xb_ld(&bar[XB_TOPGEN]) == tg, bar);
            __builtin_amdgcn_fence(__ATOMIC_ACQUIRE, "agent");
            xb_add(&bar[XB_XGEN(b.x)], 1u);
            asm volatile("s_waitcnt vmcnt(0)" ::: "memory");
        } else {
            XB_SPIN(xb_ld(&bar[XB_XGEN(b.x)]) == gen, bar);
            __builtin_amdgcn_fence(__ATOMIC_ACQUIRE, "agent");
            asm volatile("s_waitcnt vmcnt(0)" ::: "memory");
        }
    }
    __syncthreads();
}

__global__ void __launch_bounds__(512, 2) mega_fwd(Args A) {
    extern __shared__ __attribute__((aligned(16))) unsigned char lds[];
    cg::grid_group grid = cg::this_grid();
    const int tid = threadIdx.x;
    unsigned char* ws = A.ws;
    PG8_LAS unsigned char* glds = (PG8_LAS unsigned char*)lds;
    bf16* SG = (bf16*)(ws + WS_SEG);
    float* ss2 = (float*)(ws + WS_CTL + 65536); float* ss3 = (float*)(ws + WS_CTL + 262144);
    const int G = gridDim.x, c = blockIdx.x;

    if (tid == 0) { ((volatile LAS unsigned*)((LAS unsigned char*)lds + LDS_MISC))[8] = 0u; ((volatile LAS unsigned*)((LAS unsigned char*)lds + LDS_MISC))[9] = 0u; }
    __syncthreads();
    const XcdBarrier xbar = xcd_barrier_post((unsigned*)(ws + WS_BAR), (volatile LAS unsigned*)((LAS unsigned char*)lds + LDS_MISC) + 8);
#ifndef NO_P0
    p0_prologue(A, lds);
#ifdef DBL_P0
    __syncthreads();
    p0_prologue(A, lds);
#endif
#endif
    xcd_barrier(xbar);
    if (ws == nullptr) grid.sync();
#define GSYNC() xcd_barrier(xbar)
    { pg8::Gemm g{(const bf16*)(ws + WS_XN), (const bf16*)(ws + WS_WIN), M, NP, D}; pg8::StaticOrder S; S.init(M, NP, G, c);
      pg8::EpiSplit E{SG}; pg8::gemm_phase<pg8::EpiSplit, pg8::StaticOrder, true, true>(glds, g, S, E);
#ifdef DBL_G15
      pg8::gemm_phase<pg8::EpiSplit, pg8::StaticOrder, true, true>(glds, g, S, E);
#endif
    }
    GSYNC();
#ifdef DBG_FILL
    { v4u z = (v4u){0u,0u,0u,0u};
      v4u* p1 = (v4u*)(ws + WS_XN); for (size_t i = (size_t)c * 512 + tid; i < (64 * MiB) / 16; i += (size_t)G * 512) p1[i] = z;
      v4u* p2 = (v4u*)A.out; for (size_t i = (size_t)c * 512 + tid; i < (128 * MiB) / 16; i += (size_t)G * 512) p2[i] = z; }
    GSYNC();
#endif
    bf16 rawp[3][19]; float cwp[3][4], gbp[2];
    if (c < 2048) GDN_LOAD_RAW(rawp, cwp, gbp, c);
    for (int u = c; u < 2048 + 512; u += G) {
#ifndef NO_P2A
        if (u < 2048) gdn_pre_unit(A, lds, u, rawp, cwp, gbp, u + G);
#endif
#ifndef NO_P2B
        if (u >= 2048) diff_prep_unit(A, lds, u - 2048);
#endif
    }
    GSYNC();
#ifndef NO_P3
    {
        float mq = fabsf(A.q_norm[tid & 63]), mk = fabsf(A.k_norm[tid & 63]);
        float l1 = A.lq1[tid & 63] * A.lk1[tid & 63], l2 = A.lq2[tid & 63] * A.lk2[tid & 63];
#pragma unroll
        for (int o = 1; o < 64; o <<= 1) { mq = fmaxf(mq, __shfl_xor(mq, o)); mk = fmaxf(mk, __shfl_xor(mk, o)); l1 += __shfl_xor(l1, o); l2 += __shfl_xor(l2, o); }
        const float negshift = -(8.0f * mq * mk * 1.4426950408889634f + 0.5f);
        const float lam = expf(l1) - expf(l2) + 0.2f;
        LAS unsigned* misc = (LAS unsigned*)((LAS unsigned char*)lds + LDS_MISC);
        unsigned* qctr = (unsigned*)(ws + WS_CTL);
        for (;;) {
            if (tid == 0) misc[0] = atomicAdd(qctr, 1u);
            __syncthreads();
            const int it = (int)misc[0];
            __syncthreads();
            if (it >= NQ_GDN + NQ_ATT) break;
            if (it < NQ_GDN) gdn_scan_item(A, lds, it);
            else { const int j = it - NQ_GDN; attn_unit(A, lds, j & 15, 63 - (j >> 4), negshift, lam); }
        }
    }
#endif
    GSYNC();
#ifdef DBG_P2A_DIGEST
    { const bf16* qd = (const bf16*)(ws + WS_XN); const bf16* kd = (const bf16*)(ws + WS_XN + 32 * MiB);
      const bf16* ub = (const bf16*)((unsigned char*)A.out + DO_U); const bf16* wb = (const bf16*)((unsigned char*)A.out + DO_W); const bf16* ab = (const bf16*)((unsigned char*)A.out + DO_A);
      const float* eg = (const float*)(ws + WS_CTL + 524288);
      bf16* OA = SG + 2 * SEG;
      for (size_t i = (size_t)c * 512 + tid; i < SEG; i += (size_t)G * 512) {
          float v = bf2f(qd[i]) + bf2f(kd[i]) + bf2f(ub[i]) + bf2f(wb[i]) + bf2f(ab[i >> 1]) + eg[(i & 2047) * 32];
          OA[i] = (bf16)f2bf(v); } }
#endif
#ifndef NO_P4
    p4_post(A);
#endif
    GSYNC();
    { pg8::StaticOrder S; S.init(M, D, G, c);
      { pg8::Gemm g{SG + 2 * SEG, (const bf16*)(ws + WS_WOA), M, D, 512}; pg8::EpiGate<false> E{SG + 7 * SEG, (bf16*)(ws + WS_XN)};
        pg8::gemm_phase<pg8::EpiGate<false>, pg8::StaticOrder, true, true>(glds, g, S, E); }
      { pg8::Gemm g{SG + 6 * SEG, (const bf16*)(ws + WS_WOB), M, D, 512}; pg8::EpiGate<true> E{SG + 9 * SEG, (bf16*)(ws + WS_XN)};
        pg8::gemm_phase<pg8::EpiGate<true>, pg8::StaticOrder, true, true>(glds, g, S, E); } }
    GSYNC();
    { pg8::Gemm g{(const bf16*)(ws + WS_XN), (const bf16*)(ws + WS_WOUT), M, D, D}; pg8::StaticOrder S; S.init(M, D, G, c);
      pg8::EpiResB<false> E{A.x, SG + 8 * SEG, ss2}; pg8::gemm_phase<pg8::EpiResB<false>, pg8::StaticOrder, true, true>(glds, g, S, E); }
    GSYNC();
    { pg8::Gemm g{SG + 8 * SEG, (const bf16*)(ws + WS_WUP), M, FF, D}; pg8::StaticOrder S; S.init(M, FF, G, c);
      pg8::EpiUp E{SG, ss2}; pg8::gemm_phase<pg8::EpiUp, pg8::StaticOrder, true, true>(glds, g, S, E);
#ifdef DBL_G15
      pg8::gemm_phase<pg8::EpiUp, pg8::StaticOrder, true, true>(glds, g, S, E);
#endif
    }
    GSYNC();
    { pg8::Gemm g{SG, (const bf16*)(ws + WS_WDN), M, D, FF}; pg8::StaticOrder S; S.init(M, D, G, c);
      pg8::EpiResB<true> E{SG + 8 * SEG, (bf16*)(ws + WS_XN), ss3}; pg8::gemm_phase<pg8::EpiResB<true>, pg8::StaticOrder, true, true>(glds, g, S, E); }
    GSYNC();
    { pg8::StaticOrder S; S.init(M, D, G, c);
      { pg8::Gemm g{(const bf16*)(ws + WS_PBF), (const bf16*)(ws + WS_WPLE), M, D, PLE}; pg8::EpiBf E{SG};
        pg8::gemm_phase<pg8::EpiBf, pg8::StaticOrder, true, true>(glds, g, S, E); }
      { pg8::Gemm g{(const bf16*)(ws + WS_XN), (const bf16*)(ws + WS_WPG), M, D, D}; pg8::EpiPleB E{A.out, (const bf16*)(ws + WS_XN), SG, ss3};
        pg8::gemm_phase<pg8::EpiPleB, pg8::StaticOrder, true, true>(glds, g, S, E); } }
}

extern "C" void kernel_launch(void* const* d_in, const int* in_sizes, int n_in, void* d_out, int out_size, void* d_ws, size_t ws_size, hipStream_t stream) {
    static int grid = 0;
    if (grid == 0) {
        if (n_in != 25 || ws_size < WS_END || out_size != M * D) { fprintf(stderr, "kernel_launch: unexpected shapes (n_in %d, ws %zu, out %d)\n", n_in, ws_size, out_size); grid = -1; return; }
        int dev = 0, cus = 0, per_cu = 0;
        hipGetDevice(&dev); hipDeviceGetAttribute(&cus, hipDeviceAttributeMultiprocessorCount, dev);
        hipFuncSetAttribute((const void*)mega_fwd, hipFuncAttributeMaxDynamicSharedMemorySize, LDS_BYTES);
        hipOccupancyMaxActiveBlocksPerMultiprocessor(&per_cu, (const void*)mega_fwd, 512, LDS_BYTES);
        (void)hipGetLastError();
        if (per_cu < 1) per_cu = 1;
        grid = cus * 1;
    }
    if (grid < 0) return;
    Args a{};
    a.x = (const float*)d_in[0]; a.p = (const float*)d_in[1]; a.pos = (const int*)d_in[2]; a.attn_norm = (const float*)d_in[3]; a.w_in = (const float*)d_in[4];
    a.conv_w = (const float*)d_in[5]; a.a_log = (const float*)d_in[6]; a.dt_bias = (const float*)d_in[7]; a.gdn_norm = (const float*)d_in[8]; a.w_o_a = (const float*)d_in[9];
    a.q_norm = (const float*)d_in[10]; a.k_norm = (const float*)d_in[11]; a.lq1 = (const float*)d_in[12]; a.lk1 = (const float*)d_in[13]; a.lq2 = (const float*)d_in[14]; a.lk2 = (const float*)d_in[15];
    a.diff_norm = (const float*)d_in[16]; a.w_o_b = (const float*)d_in[17]; a.w_out = (const float*)d_in[18]; a.mlp_norm = (const float*)d_in[19]; a.w_up = (const float*)d_in[20];
    a.w_down = (const float*)d_in[21]; a.ple_norm = (const float*)d_in[22]; a.w_ple_gate = (const float*)d_in[23]; a.w_ple = (const float*)d_in[24];
    a.out = (float*)d_out; a.ws = (unsigned char*)d_ws;
    (void)hipMemsetAsync(d_ws, 0, 1 * MiB, stream);
    void* args[] = {&a};
    hipError_t e = hipLaunchCooperativeKernel((const void*)mega_fwd, dim3(grid), dim3(512), args, LDS_BYTES, stream);
    if (e != hipSuccess) fprintf(stderr, "cooperative launch failed: %s (grid %d)\n", hipGetErrorString(e), grid);
}
```

```cpp
#include <hip/hip_runtime.h>
#include <hip/hip_cooperative_groups.h>
#include <cstdio>
#include <cstdint>
namespace cg = cooperative_groups;
namespace pg8 {
#define PG8_LAS __attribute__((address_space(3)))
typedef unsigned short bf16_t;
typedef short bf16x8 __attribute__((ext_vector_type(8)));
typedef float f32x4 __attribute__((ext_vector_type(4)));
typedef unsigned u32x4 __attribute__((ext_vector_type(4)));
constexpr int BM = 256, BK = 64, HALF = 128, HTB = HALF * BK * 2  , STAGE_BYTES = 8 * HTB, NXCD = 8, WGM = 4;

__host__ __device__ __forceinline__ int lds_byte(int r, int c) { const int st = (r >> 4) * 2 + (c >> 5), rr = r & 15, cc = c & 31, ob = rr * 64 + cc * 2; return st * 1024 + (ob ^ (((ob >> 9) & 1) << 5)); }
__host__ __device__ __forceinline__ void stage_rc(int b, int& R, int& C) { const int st = b / 1024, sb = b % 1024, swz = sb ^ (((sb >> 9) & 1) << 5); R = (st >> 1) * 16 + swz / 64; C = (st & 1) * 32 + (swz % 64) / 2; }
__host__ __device__ __forceinline__ int perm32(int rho) { const int n = rho >> 4, i = rho & 15; return 8 * (i >> 2) + 4 * n + (i & 3); }

struct Unit { int pm, pn; };
struct Gemm { const bf16_t* A; const bf16_t* Bt; int M, N, K; };

struct StaticOrder {
    int nM, nN, nwg, G, c;
    __host__ __device__ void init(int M, int N, int G_, int c_) { nM = M / BM; nN = N / BM; nwg = nM * nN; G = G_; c = c_; }
    __host__ __device__ bool next(int i, Unit& u) const {
        const long L = (long)i * G + c; if (L >= nwg) return false;
        int wgid = (int)L; { const int q = nwg / NXCD, r = nwg % NXCD, xcd = wgid % NXCD, off = wgid / NXCD; wgid = (xcd < r ? xcd * (q + 1) : r * (q + 1) + (xcd - r) * q) + off; }
        const int nig = WGM * nN, gid = wgid / nig, fm = gid * WGM, gsz = (nM - fm) < WGM ? (nM - fm) : WGM;
        u.pm = fm + ((wgid % nig) % gsz); u.pn = (wgid % nig) / gsz; return true;
    }
    __device__ __forceinline__ void a_ready(const Unit&) const {}
    __device__ __forceinline__ void done(const Unit&) const {}
};

__device__ __forceinline__ unsigned cvt_pk_bf16(float lo, float hi) { unsigned r; asm volatile("v_cvt_pk_bf16_f32 %0, %1, %2" : "=v"(r) : "v"(lo), "v"(hi)); return r; }
typedef float f32x2 __attribute__((ext_vector_type(2)));
constexpr int EM = 32768;
constexpr size_t ESEG = (size_t)EM * 512;
__device__ __forceinline__ float bf2f(unsigned short b) { return __uint_as_float((unsigned)b << 16); }
__device__ __forceinline__ float bflo(unsigned w) { return __uint_as_float(w << 16); }
__device__ __forceinline__ float bfhi(unsigned w) { return __uint_as_float(w & 0xffff0000u); }
__device__ __forceinline__ float sigm(float x) { return 1.0f / (1.0f + __expf(-x)); }
__device__ __forceinline__ u32x4 pack8(const f32x4& v0, const f32x4& v1) { u32x4 w; w.x = cvt_pk_bf16(v0[0], v0[1]); w.y = cvt_pk_bf16(v0[2], v0[3]); w.z = cvt_pk_bf16(v1[0], v1[1]); w.w = cvt_pk_bf16(v1[2], v1[3]); return w; }
__device__ __forceinline__ void unpack8(const u32x4& w, f32x4& v0, f32x4& v1) { v0 = (f32x4){bflo(w.x), bfhi(w.x), bflo(w.y), bfhi(w.y)}; v1 = (f32x4){bflo(w.z), bfhi(w.z), bflo(w.w), bfhi(w.w)}; }

struct EpiSplit {
    static constexpr bool PERM = true, AFTER_DRAIN = false;
    bf16_t* O;
    __device__ __forceinline__ void operator()(const f32x4 (&acc)[2][2][4][2], const Unit& u, int wr, int wc, int fr, int fq) const {
        const int row0 = u.pm * BM + wr * 64 + fr; const int colt = u.pn * BM; const int seg = colt >> 9, cin = colt & 511;
        bf16_t* base = O + (size_t)seg * ESEG + cin + wc * 32 + 8 * fq;
#pragma unroll
        for (int ai = 0; ai < 2; ++ai)
#pragma unroll
            for (int m = 0; m < 4; ++m) { asm volatile("" ::: "memory"); bf16_t* rowp = base + (size_t)(row0 + ai * HALF + m * 16) * 512;
#pragma unroll
                for (int bj = 0; bj < 2; ++bj) *(u32x4*)(rowp + bj * HALF) = pack8(acc[ai][bj][m][0], acc[ai][bj][m][1]); }
    }
};
template <bool ADD> struct EpiGate {
    static constexpr bool PERM = true, AFTER_DRAIN = false;
    const bf16_t* G; bf16_t* Tt;
    __device__ __forceinline__ void operator()(const f32x4 (&acc)[2][2][4][2], const Unit& u, int wr, int wc, int fr, int fq) const {
        const int row0 = u.pm * BM + wr * 64 + fr; const int colt = u.pn * BM; const int seg = colt >> 9, cin = colt & 511;
        const bf16_t* gbase = G + (size_t)seg * ESEG + cin + wc * 32 + 8 * fq;
        bf16_t* tbase = Tt + colt + wc * 32 + 8 * fq;
#pragma unroll
        for (int ai = 0; ai < 2; ++ai)
#pragma unroll
            for (int m = 0; m < 4; ++m) { asm volatile("" ::: "memory"); const size_t row = (size_t)(row0 + ai * HALF + m * 16);
#pragma unroll
                for (int bj = 0; bj < 2; ++bj) {
                    const u32x4 gw = *(const u32x4*)(gbase + row * 512 + bj * HALF); f32x4 g0, g1; unpack8(gw, g0, g1);
                    f32x4 v0 = acc[ai][bj][m][0], v1 = acc[ai][bj][m][1];
#pragma unroll
                    for (int e = 0; e < 4; ++e) { v0[e] *= sigm(g0[e]); v1[e] *= sigm(g1[e]); }
                    bf16_t* tp = tbase + row * 1024 + bj * HALF;
                    if (ADD) { const u32x4 tw = *(const u32x4*)tp; f32x4 t0, t1; unpack8(tw, t0, t1); v0 += t0; v1 += t1; }
                    *(u32x4*)tp = pack8(v0, v1); } }
    }
};
struct EpiRes {
    static constexpr bool PERM = true, AFTER_DRAIN = false;
    const float* base; float* out; bf16_t* XB; float* SS;
    __device__ __forceinline__ void operator()(const f32x4 (&acc)[2][2][4][2], const Unit& u, int wr, int wc, int fr, int fq) const {
        const int row0 = u.pm * BM + wr * 64 + fr; const int col0 = u.pn * BM + wc * 32 + 8 * fq;
#pragma unroll
        for (int ai = 0; ai < 2; ++ai)
#pragma unroll
            for (int m = 0; m < 4; ++m) { asm volatile("" ::: "memory"); const size_t row = (size_t)(row0 + ai * HALF + m * 16); float ss = 0.f;
#pragma unroll
                for (int bj = 0; bj < 2; ++bj) { const size_t off = row * 1024 + col0 + bj * HALF;
                    const f32x4 b0 = *(const f32x4*)(base + off), b1 = *(const f32x4*)(base + off + 4);
                    const f32x4 v0 = acc[ai][bj][m][0] + b0, v1 = acc[ai][bj][m][1] + b1;
                    *(f32x4*)(out + off) = v0; *(f32x4*)(out + off + 4) = v1;
                    *(u32x4*)(XB + off) = pack8(v0, v1);
                    ss += (v0[0] * v0[0] + v0[1] * v0[1]) + (v0[2] * v0[2] + v0[3] * v0[3]) + (v1[0] * v1[0] + v1[1] * v1[1]) + (v1[2] * v1[2] + v1[3] * v1[3]); }
                ss += __shfl_xor(ss, 16); ss += __shfl_xor(ss, 32);
                if (fq == 0) atomicAdd(SS + row, ss); }
    }
};
struct EpiUp {
    static constexpr bool PERM = true, AFTER_DRAIN = false;
    bf16_t* U; const float* SS;
    __device__ __forceinline__ void operator()(const f32x4 (&acc)[2][2][4][2], const Unit& u, int wr, int wc, int fr, int fq) const {
        const int row0 = u.pm * BM + wr * 64 + fr; const int col0 = u.pn * BM + wc * 32 + 8 * fq;
#pragma unroll
        for (int ai = 0; ai < 2; ++ai)
#pragma unroll
            for (int m = 0; m < 4; ++m) { asm volatile("" ::: "memory"); const size_t row = (size_t)(row0 + ai * HALF + m * 16);
                const float rstd = rsqrtf(SS[row] * (1.0f / 1024.0f) + 1e-6f);
#pragma unroll
                for (int bj = 0; bj < 2; ++bj) { f32x4 v0 = acc[ai][bj][m][0] * rstd, v1 = acc[ai][bj][m][1] * rstd;
#pragma unroll
                    for (int e = 0; e < 4; ++e) { const float a = fmaxf(v0[e], 0.f), b = fmaxf(v1[e], 0.f); v0[e] = a * a; v1[e] = b * b; }
                    *(u32x4*)(U + row * 4096 + col0 + bj * HALF) = pack8(v0, v1); } }
    }
};
struct EpiF32 {
    static constexpr bool PERM = false, AFTER_DRAIN = false;
    float* O;
    __device__ __forceinline__ void operator()(const f32x4 (&acc)[2][2][4][2], const Unit& u, int wr, int wc, int fr, int fq) const {
        const int row0 = u.pm * BM + wr * 64 + fr; const int col0 = u.pn * BM + wc * 32 + 4 * fq;
#pragma unroll
        for (int ai = 0; ai < 2; ++ai)
#pragma unroll
            for (int m = 0; m < 4; ++m) { asm volatile("" ::: "memory"); const size_t row = (size_t)(row0 + ai * HALF + m * 16);
#pragma unroll
                for (int bj = 0; bj < 2; ++bj)
#pragma unroll
                    for (int n = 0; n < 2; ++n) *(f32x4*)(O + row * 1024 + col0 + bj * HALF + n * 16) = acc[ai][bj][m][n]; }
    }
};
struct EpiPle {
    static constexpr bool PERM = false, AFTER_DRAIN = false;
    float* out; const float* P; const float* SS;
    __device__ __forceinline__ void operator()(const f32x4 (&acc)[2][2][4][2], const Unit& u, int wr, int wc, int fr, int fq) const {
        const int row0 = u.pm * BM + wr * 64 + fr; const int col0 = u.pn * BM + wc * 32 + 4 * fq;
#pragma unroll
        for (int ai = 0; ai < 2; ++ai)
#pragma unroll
            for (int m = 0; m < 4; ++m) { asm volatile("" ::: "memory"); const size_t row = (size_t)(row0 + ai * HALF + m * 16);
                const float rstd = rsqrtf(SS[row] * (1.0f / 1024.0f) + 1e-6f);
#pragma unroll
                for (int bj = 0; bj < 2; ++bj)
#pragma unroll
                    for (int n = 0; n < 2; ++n) { const size_t off = row * 1024 + col0 + bj * HALF + n * 16;
                        const f32x4 x = *(const f32x4*)(out + off), pl = *(const f32x4*)(P + off); f32x4 v = acc[ai][bj][m][n] * rstd;
#pragma unroll
                        for (int e = 0; e < 4; ++e) v[e] = x[e] + sigm(v[e]) * pl[e];
                        *(f32x4*)(out + off) = v; } }
    }
};

template <bool BASE_BF16> struct EpiResB {
    static constexpr bool PERM = true, AFTER_DRAIN = false;
    const void* base; bf16_t* XB; float* SS;
    __device__ __forceinline__ void operator()(const f32x4 (&acc)[2][2][4][2], const Unit& u, int wr, int wc, int fr, int fq) const {
        const int row0 = u.pm * BM + wr * 64 + fr; const int col0 = u.pn * BM + wc * 32 + 8 * fq;
#pragma unroll
        for (int ai = 0; ai < 2; ++ai)
#pragma unroll
            for (int m = 0; m < 4; ++m) { asm volatile("" ::: "memory"); const size_t row = (size_t)(row0 + ai * HALF + m * 16); float ss = 0.f;
#pragma unroll
                for (int bj = 0; bj < 2; ++bj) { const size_t off = row * 1024 + col0 + bj * HALF; f32x4 b0, b1;
                    if (BASE_BF16) { const u32x4 bw = *(const u32x4*)((const bf16_t*)base + off); unpack8(bw, b0, b1); }
                    else { b0 = *(const f32x4*)((const float*)base + off); b1 = *(const f32x4*)((const float*)base + off + 4); }
                    const f32x4 v0 = acc[ai][bj][m][0] + b0, v1 = acc[ai][bj][m][1] + b1;
                    *(u32x4*)(XB + off) = pack8(v0, v1);
                    ss += (v0[0] * v0[0] + v0[1] * v0[1]) + (v0[2] * v0[2] + v0[3] * v0[3]) + (v1[0] * v1[0] + v1[1] * v1[1]) + (v1[2] * v1[2] + v1[3] * v1[3]); }
                ss += __shfl_xor(ss, 16); ss += __shfl_xor(ss, 32);
                if (fq == 0) atomicAdd(SS + row, ss); }
    }
};
struct EpiBf {
    static constexpr bool PERM = true, AFTER_DRAIN = false;
    bf16_t* O;
    __device__ __forceinline__ void operator()(const f32x4 (&acc)[2][2][4][2], const Unit& u, int wr, int wc, int fr, int fq) const {
        const int row0 = u.pm * BM + wr * 64 + fr; const int col0 = u.pn * BM + wc * 32 + 8 * fq;
#pragma unroll
        for (int ai = 0; ai < 2; ++ai)
#pragma unroll
            for (int m = 0; m < 4; ++m) { asm volatile("" ::: "memory"); const size_t row = (size_t)(row0 + ai * HALF + m * 16);
#pragma unroll
                for (int bj = 0; bj < 2; ++bj) *(u32x4*)(O + row * 1024 + col0 + bj * HALF) = pack8(acc[ai][bj][m][0], acc[ai][bj][m][1]); }
    }
};
struct EpiPleB {
    static constexpr bool PERM = true, AFTER_DRAIN = false;
    float* out; const bf16_t* XB; const bf16_t* P; const float* SS;
    __device__ __forceinline__ void operator()(const f32x4 (&acc)[2][2][4][2], const Unit& u, int wr, int wc, int fr, int fq) const {
        const int row0 = u.pm * BM + wr * 64 + fr; const int col0 = u.pn * BM + wc * 32 + 8 * fq;
#pragma unroll
        for (int ai = 0; ai < 2; ++ai)
#pragma unroll
            for (int m = 0; m < 4; ++m) { asm volatile("" ::: "memory"); const size_t row = (size_t)(row0 + ai * HALF + m * 16);
                const float rstd = rsqrtf(SS[row] * (1.0f / 1024.0f) + 1e-6f);
#pragma unroll
                for (int bj = 0; bj < 2; ++bj) { const size_t off = row * 1024 + col0 + bj * HALF;
                    const u32x4 xw = *(const u32x4*)(XB + off), pw = *(const u32x4*)(P + off); f32x4 x0, x1, p0, p1; unpack8(xw, x0, x1); unpack8(pw, p0, p1);
                    f32x4 v0 = acc[ai][bj][m][0] * rstd, v1 = acc[ai][bj][m][1] * rstd;
#pragma unroll
                    for (int e2 = 0; e2 < 4; ++e2) { v0[e2] = x0[e2] + sigm(v0[e2]) * p0[e2]; v1[e2] = x1[e2] + sigm(v1[e2]) * p1[e2]; }
                    *(f32x4*)(out + off) = v0; *(f32x4*)(out + off + 4) = v1; } }
    }
};
template <class Epi, class Sched, bool ALIGN_EPI = false, bool SP2 = false>
__device__ __forceinline__ void gemm_phase(PG8_LAS unsigned char* lds, const Gemm g, const Sched& S, const Epi& E) {
    int tid_ = threadIdx.x; asm volatile("" : "+v"(tid_)); const int tid = tid_, wid = __builtin_amdgcn_readfirstlane(tid >> 6), lane = tid & 63, wr = wid >> 2, wc = wid & 3, fr = lane & 15, fq = lane >> 4;
    const int K = g.K, nt = K / BK;
    unsigned voffA[2], voffB[2];
#pragma unroll
    for (int i = 0; i < 2; ++i) { int R, C; stage_rc(tid * 16 + i * 8192, R, C); const int Rb = Epi::PERM ? ((R & ~31) + perm32(R & 31)) : R;
        voffA[i] = (unsigned)(R * K + C) * 2u; voffB[i] = (unsigned)(Rb * K + C) * 2u; }
    const size_t kstep = (size_t)(BK * 2);
    const size_t hstep = (size_t)HALF * K * 2;
    const size_t tstep = 2 * hstep;
    const unsigned ldsw = (unsigned)wid * 1024u;
    const int aoff = lds_byte(wr * 64 + fr, fq * 8), boff = lds_byte(wc * 32 + fr, fq * 8);
#define PG8_SA(b, h) (((b) * 2 + (h)) * HTB)
#define PG8_SB(b, h) ((4 + (b) * 2 + (h)) * HTB)
#define PG8_STAGE(bufoff, gbase, voff) do { _Pragma("unroll") for (int _i = 0; _i < 2; ++_i) \
        __builtin_amdgcn_global_load_lds((const unsigned*)((const char*)(gbase) + (voff)[_i]), (PG8_LAS unsigned*)(lds + (bufoff) + ldsw + _i * 8192), 16, 0, 0); } while (0)
#define PG8_LDA(dst, b, h) do { _Pragma("unroll") for (int m = 0; m < 4; ++m) _Pragma("unroll") for (int k = 0; k < 2; ++k) dst[m][k] = *(const PG8_LAS bf16x8*)(lds + PG8_SA(b, h) + aoff + m * 2048 + k * 1024); } while (0)
#define PG8_LDB(dst, b, h) do { _Pragma("unroll") for (int n = 0; n < 2; ++n) _Pragma("unroll") for (int k = 0; k < 2; ++k) dst[n][k] = *(const PG8_LAS bf16x8*)(lds + PG8_SB(b, h) + boff + n * 2048 + k * 1024); } while (0)
#define PG8_MMA(ai, bj, At, Bt) do { __builtin_amdgcn_s_setprio(1); _Pragma("unroll") for (int m = 0; m < 4; ++m) _Pragma("unroll") for (int n = 0; n < 2; ++n) _Pragma("unroll") for (int k = 0; k < 2; ++k) \
        acc[ai][bj][m][n] = __builtin_amdgcn_mfma_f32_16x16x32_bf16(Bt[n][k], At[m][k], acc[ai][bj][m][n], 0, 0, 0); __builtin_amdgcn_s_setprio(0); } while (0)
#define PG8_WAIT_V(n) asm volatile("s_waitcnt vmcnt(" #n ")" ::: "memory")
#define PG8_WAIT_L(n) asm volatile("s_waitcnt lgkmcnt(" #n ")" ::: "memory")
#define PG8_BAR __builtin_amdgcn_s_barrier()
#define PG8_SCHED __builtin_amdgcn_sched_barrier(0)
    Unit cur, nxt; int ui = 0;
    if (!S.next(0, cur)) return;
    f32x4 acc[2][2][4][2];
#pragma unroll
    for (int a = 0; a < 2; ++a)
#pragma unroll
        for (int b = 0; b < 2; ++b)
#pragma unroll
            for (int m = 0; m < 4; ++m)
#pragma unroll
                for (int n = 0; n < 2; ++n) acc[a][b][m][n] = (f32x4){0.f, 0.f, 0.f, 0.f};
    bf16x8 At[4][2], B0[2][2], B1[2][2];
    const char* cA = (const char*)g.A + (size_t)cur.pm * tstep; const char* cB = (const char*)g.Bt + (size_t)cur.pn * tstep;
    S.a_ready(cur);
    if constexpr (SP2) {
        PG8_STAGE(PG8_SB(0, 0), cB, voffB); PG8_STAGE(PG8_SB(0, 1), cB + hstep, voffB); PG8_STAGE(PG8_SA(0, 0), cA, voffA); PG8_STAGE(PG8_SA(0, 1), cA + hstep, voffA);
        if (wr == 1) PG8_BAR;
        PG8_WAIT_V(2); PG8_BAR;
        PG8_STAGE(PG8_SB(1, 0), cB + kstep, voffB); PG8_STAGE(PG8_SA(1, 0), cA + kstep, voffA); PG8_STAGE(PG8_SB(1, 1), cB + hstep + kstep, voffB);
        PG8_WAIT_V(6); PG8_BAR;
    } else {
        PG8_STAGE(PG8_SB(0, 0), cB, voffB); PG8_STAGE(PG8_SA(0, 0), cA, voffA); PG8_STAGE(PG8_SB(0, 1), cB + hstep, voffB); PG8_STAGE(PG8_SA(0, 1), cA + hstep, voffA);
        if (wr == 1) PG8_BAR;
        PG8_WAIT_V(4); PG8_BAR;
        PG8_STAGE(PG8_SB(1, 0), cB + kstep, voffB); PG8_STAGE(PG8_SA(1, 0), cA + kstep, voffA); PG8_STAGE(PG8_SB(1, 1), cB + hstep + kstep, voffB);
        PG8_WAIT_V(6); PG8_BAR;
    }
    for (;;) {
        const bool has_next = S.next(ui + 1, nxt);
        const char* nA = has_next ? (const char*)g.A + (size_t)nxt.pm * tstep : cA; const char* nB = has_next ? (const char*)g.Bt + (size_t)nxt.pn * tstep : cB;
        for (int t = 0; t < nt; t += 2) {
            const bool last = (t == nt - 2);
            const char* a1 = cA + (size_t)(t + 1) * kstep;
            const char* a2 = last ? nA : cA + (size_t)(t + 2) * kstep; const char* b2 = last ? nB : cB + (size_t)(t + 2) * kstep;
            const char* a3 = a2 + kstep; const char* b3 = b2 + kstep;
            if (last && has_next) S.a_ready(nxt);
            if constexpr (SP2) {
            PG8_LDB(B0, 0, 0); PG8_LDB(B1, 0, 1); PG8_SCHED; PG8_LDA(At, 0, 0); PG8_STAGE(PG8_SA(1, 1), a1 + hstep, voffA);
            PG8_WAIT_V(8); PG8_WAIT_L(0); PG8_BAR; PG8_MMA(0, 0, At, B0); PG8_MMA(0, 1, At, B1); PG8_BAR; PG8_SCHED;
            PG8_LDA(At, 0, 1); PG8_STAGE(PG8_SB(0, 0), b2, voffB); PG8_STAGE(PG8_SB(0, 1), b2 + hstep, voffB); PG8_STAGE(PG8_SA(0, 0), a2, voffA);
            PG8_WAIT_V(8); PG8_WAIT_L(0); PG8_BAR; PG8_MMA(1, 0, At, B0); PG8_MMA(1, 1, At, B1); PG8_BAR; PG8_SCHED;
            PG8_LDB(B0, 1, 0); PG8_LDB(B1, 1, 1); PG8_SCHED; PG8_LDA(At, 1, 0); PG8_STAGE(PG8_SA(0, 1), a2 + hstep, voffA);
            PG8_WAIT_V(8); PG8_WAIT_L(0); PG8_BAR; PG8_MMA(0, 0, At, B0); PG8_MMA(0, 1, At, B1); PG8_BAR; PG8_SCHED;
            PG8_LDA(At, 1, 1); PG8_STAGE(PG8_SB(1, 0), b3, voffB); PG8_STAGE(PG8_SB(1, 1), b3 + hstep, voffB); PG8_STAGE(PG8_SA(1, 0), a3, voffA);
            PG8_WAIT_V(8); PG8_WAIT_L(0); PG8_BAR; PG8_MMA(1, 0, At, B0); PG8_MMA(1, 1, At, B1); PG8_BAR; PG8_SCHED;
            } else {
            PG8_LDB(B0, 0, 0); PG8_SCHED; PG8_LDA(At, 0, 0); PG8_STAGE(PG8_SA(1, 1), a1 + hstep, voffA);
            PG8_WAIT_L(8); PG8_BAR; PG8_WAIT_L(0); PG8_MMA(0, 0, At, B0); PG8_BAR; PG8_SCHED;
            PG8_LDB(B1, 0, 1); PG8_STAGE(PG8_SB(0, 0), b2, voffB);
            PG8_BAR; PG8_WAIT_L(0); PG8_MMA(0, 1, At, B1); PG8_BAR;
            PG8_LDA(At, 0, 1); PG8_STAGE(PG8_SA(0, 0), a2, voffA);
            PG8_BAR; PG8_WAIT_L(0); PG8_MMA(1, 0, At, B0); PG8_BAR; PG8_SCHED;
            PG8_STAGE(PG8_SB(0, 1), b2 + hstep, voffB);
            PG8_WAIT_V(6); PG8_BAR; PG8_MMA(1, 1, At, B1); PG8_BAR;
            PG8_LDB(B0, 1, 0); PG8_SCHED; PG8_LDA(At, 1, 0); PG8_STAGE(PG8_SA(0, 1), a2 + hstep, voffA);
            PG8_WAIT_L(8); PG8_BAR; PG8_WAIT_L(0); PG8_MMA(0, 0, At, B0); PG8_BAR; PG8_SCHED;
            PG8_LDB(B1, 1, 1); PG8_STAGE(PG8_SB(1, 0), b3, voffB);
            PG8_BAR; PG8_WAIT_L(0); PG8_MMA(0, 1, At, B1); PG8_BAR;
            PG8_LDA(At, 1, 1); PG8_STAGE(PG8_SA(1, 0), a3, voffA);
            PG8_BAR; PG8_WAIT_L(0); PG8_MMA(1, 0, At, B0); PG8_BAR; PG8_SCHED;
            PG8_STAGE(PG8_SB(1, 1), b3 + hstep, voffB);
            PG8_WAIT_V(6); PG8_BAR; PG8_MMA(1, 1, At, B1); PG8_BAR;
            }
        }
        if constexpr (ALIGN_EPI) { if (wr == 0) PG8_BAR; }
        if constexpr (!Epi::AFTER_DRAIN) { E(acc, cur, wr, wc, fr, fq); S.done(cur); }
        if (!has_next) break;
#pragma unroll
        for (int a = 0; a < 2; ++a)
#pragma unroll
            for (int b = 0; b < 2; ++b)
#pragma unroll
                for (int m = 0; m < 4; ++m)
#pragma unroll
                    for (int n = 0; n < 2; ++n) acc[a][b][m][n] = (f32x4){0.f, 0.f, 0.f, 0.f};
        cur = nxt; cA = nA; cB = nB; ++ui;
        if constexpr (ALIGN_EPI) { if (wr == 1) PG8_BAR; }
    }
    PG8_WAIT_V(0);
    if constexpr (!ALIGN_EPI) { if (wr == 0) PG8_BAR; }
    PG8_BAR;
    if constexpr (Epi::AFTER_DRAIN) { E.fused(acc, cur, wr, wc, fr, fq, lds, wid, lane); S.done(cur); }
#undef PG8_SA
#undef PG8_SB
#undef PG8_STAGE
#undef PG8_LDA
#undef PG8_LDB
#undef PG8_MMA
#undef PG8_WAIT_V
#undef PG8_WAIT_L
#undef PG8_BAR
#undef PG8_SCHED
}
}

#define LAS __attribute__((address_space(3)))
typedef unsigned short bf16;
typedef unsigned v4u __attribute__((ext_vector_type(4)));
typedef unsigned v2u __attribute__((ext_vector_type(2)));
typedef float f32x4 __attribute__((ext_vector_type(4)));
typedef float f32x16 __attribute__((ext_vector_type(16)));
typedef short bf16x8 __attribute__((ext_vector_type(8)));
typedef short bf16x4 __attribute__((ext_vector_type(4)));

constexpr int NB = 4, T = 8192, M = NB * T, D = 1024, DIN = 5640, NP = 5632, FF = 4096, PLE = 256;
constexpr float EPS = 1e-6f;
constexpr size_t MiB = 1u << 20;
constexpr size_t SEG = (size_t)M * 512;
constexpr size_t WS_CTL = 0;
constexpr size_t WS_BAR = 768 * 1024;
constexpr size_t WS_GB = 1 * MiB;
constexpr size_t WS_WIN = 2 * MiB, WS_WOA = 13 * MiB, WS_WOB = 14 * MiB, WS_WOUT = 15 * MiB, WS_WUP = 17 * MiB, WS_WDN = 25 * MiB, WS_WPG = 33 * MiB, WS_WPLE = 35 * MiB;
constexpr size_t WS_PBF = 36 * MiB;
constexpr size_t WS_XN = 52 * MiB;
constexpr size_t WS_SEG = 116 * MiB;
constexpr size_t WS_END = WS_SEG + 11 * 32 * MiB;
constexpr size_t DO_U = 0, DO_W = 32 * MiB, DO_A = 64 * MiB, DO_VT = 80 * MiB;

constexpr int LDS_MISC = 131072, LDS_BYTES = 131072 + 1024;
constexpr int NQ_GDN = 16, NQ_ATT = 1024;

__device__ __forceinline__ unsigned f2bf(float f) { unsigned u = __builtin_bit_cast(unsigned, f); return (u + 0x7fffu + ((u >> 16) & 1u)) >> 16; }
typedef float f32x2_t __attribute__((ext_vector_type(2))); typedef __bf16 bf16x2_t __attribute__((ext_vector_type(2)));
__device__ __forceinline__ unsigned pk2(float lo, float hi) { f32x2_t v = {lo, hi}; bf16x2_t b = __builtin_convertvector(v, bf16x2_t); return __builtin_bit_cast(unsigned, b); }
__device__ __forceinline__ float bf2f(unsigned short b) { return __uint_as_float((unsigned)b << 16); }
__device__ __forceinline__ float bflo(unsigned w) { return __uint_as_float(w << 16); }
__device__ __forceinline__ float bfhi(unsigned w) { return __uint_as_float(w & 0xffff0000u); }
__device__ __forceinline__ float wave_sum(float v);
__device__ __forceinline__ float silu(float x) { return x / (1.0f + __expf(-x)); }
__device__ __forceinline__ float dpp_xor1(float v) { return __builtin_bit_cast(float, __builtin_amdgcn_mov_dpp(__builtin_bit_cast(int, v), 0xB1, 0xF, 0xF, false)); }
__device__ __forceinline__ float dpp_xor2(float v) { return __builtin_bit_cast(float, __builtin_amdgcn_mov_dpp(__builtin_bit_cast(int, v), 0x4E, 0xF, 0xF, false)); }
__device__ __forceinline__ float dpp_hmirror(float v) { return __builtin_bit_cast(float, __builtin_amdgcn_mov_dpp(__builtin_bit_cast(int, v), 0x141, 0xF, 0xF, false)); }
__device__ __forceinline__ float dpp_ror4(float v) { return __builtin_bit_cast(float, __builtin_amdgcn_mov_dpp(__builtin_bit_cast(int, v), 0x124, 0xF, 0xF, false)); }
__device__ __forceinline__ float dpp_ror8(float v) { return __builtin_bit_cast(float, __builtin_amdgcn_mov_dpp(__builtin_bit_cast(int, v), 0x128, 0xF, 0xF, false)); }
__device__ __forceinline__ float dpp_rmirror(float v) { return __builtin_bit_cast(float, __builtin_amdgcn_mov_dpp(__builtin_bit_cast(int, v), 0x140, 0xF, 0xF, false)); }
__device__ __forceinline__ float xrow_sum(float v) {
    const auto r16 = __builtin_amdgcn_permlane16_swap(__float_as_uint(v), __float_as_uint(v), false, false);
    const float a = __uint_as_float(r16[0]) + __uint_as_float(r16[1]);
    const auto r32 = __builtin_amdgcn_permlane32_swap(__float_as_uint(a), __float_as_uint(a), false, false);
    return __uint_as_float(r32[0]) + __uint_as_float(r32[1]);
}
__device__ __forceinline__ float wave_sum(float v) { v += dpp_xor1(v); v += dpp_xor2(v); v += dpp_ror4(v); v += dpp_ror8(v); return xrow_sum(v); }
#define LDS_WAIT() asm volatile("s_waitcnt lgkmcnt(0)" ::: "memory")
#define LBAR() asm volatile("s_waitcnt lgkmcnt(0)\n\ts_barrier" ::: "memory")

struct Args {
    const float* x; const float* p; const int* pos; const float* attn_norm; const float* w_in; const float* conv_w; const float* a_log; const float* dt_bias; const float* gdn_norm;
    const float* w_o_a; const float* q_norm; const float* k_norm; const float* lq1; const float* lk1; const float* lq2; const float* lk2; const float* diff_norm; const float* w_o_b;
    const float* w_out; const float* mlp_norm; const float* w_up; const float* w_down; const float* ple_norm; const float* w_ple_gate; const float* w_ple;
    float* out; unsigned char* ws;
};

__device__ __forceinline__ void transpose_item(const float* W, int ldw, int K, bf16* WT, int n0_dst, int n0_src, int k0, const float* ks, LAS float* scr, int lane) {
    f32x4 ld[8];
#pragma unroll
    for (int i = 0; i < 8; ++i) { const int kk = 8 * i + (lane >> 3); ld[i] = *(const f32x4*)(W + (size_t)(k0 + kk) * ldw + n0_src + 4 * (lane & 7)); }
#pragma unroll
    for (int i = 0; i < 8; ++i) { const int kk = 8 * i + (lane >> 3); f32x4 v = ld[i]; if (ks) v = v * ks[k0 + kk];
        LAS float* d = scr + kk * 33 + 4 * (lane & 7); d[0] = v.x; d[1] = v.y; d[2] = v.z; d[3] = v.w; }
    LDS_WAIT(); asm volatile("" ::: "memory");
    const int c = lane & 7;
#pragma unroll
    for (int j = 0; j < 4; ++j) { const int n = (lane >> 3) + 8 * j; const LAS float* s = scr + (8 * c) * 33 + n;
        v4u o; o.x = pk2(s[0 * 33], s[1 * 33]); o.y = pk2(s[2 * 33], s[3 * 33]); o.z = pk2(s[4 * 33], s[5 * 33]); o.w = pk2(s[6 * 33], s[7 * 33]);
        *(v4u*)(WT + (size_t)(n0_dst + n) * K + k0 + 8 * c) = o; }
    LDS_WAIT(); asm volatile("" ::: "memory");
}
__device__ __forceinline__ void tr_matrix(int r, const float* W, int ldw, int K, int N, bf16* WT, const float* ks, bool win, LAS float* scr, int lane) {
    const int nblk = N / 32, kb = r / nblk, nb = r % nblk, n0 = 32 * nb; const int n0s = (win && n0 >= 2048) ? n0 + 8 : n0;
    transpose_item(W, ldw, K, WT, n0, n0s, 64 * kb, ks, scr, lane);
}
__device__ __forceinline__ void p0_prologue(const Args& A, unsigned char* lds_g) {
    LAS unsigned char* lds = (LAS unsigned char*)lds_g;
    int tid_ = threadIdx.x; asm volatile("" : "+v"(tid_)); const int tid = tid_, lane = tid & 63, wave = __builtin_amdgcn_readfirstlane(tid >> 6);
    unsigned char* ws = A.ws;
    LAS float* scr = (LAS float*)(lds + wave * 8448);
    LAS float* Wab = (LAS float*)(lds + 8 * 8448);
    for (int e = tid; e < 8192; e += 512) Wab[(e & 7) * 1024 + (e >> 3)] = A.w_in[(size_t)(e >> 3) * DIN + 2048 + (e & 7)];
    __syncthreads();
    const int gw = blockIdx.x * 8 + wave, NGW = gridDim.x * 8;
    constexpr int I1 = 16 * 176, I2 = 8 * 32, I3 = I2, I4 = 16 * 32, I5 = 16 * 128, I6 = 64 * 32, I7 = 16 * 32, I8 = 4 * 32;
    constexpr int NITEMS = I1 + I2 + I3 + I4 + I5 + I6 + I7 + I8;
    for (int it = gw; it < NITEMS; it += NGW) {
        int r = it;
        if (r < I1) { tr_matrix(r, A.w_in, DIN, D, NP, (bf16*)(ws + WS_WIN), nullptr, true, scr, lane); continue; } r -= I1;
        if (r < I2) { tr_matrix(r, A.w_o_a, D, 512, D, (bf16*)(ws + WS_WOA), nullptr, false, scr, lane); continue; } r -= I2;
        if (r < I3) { tr_matrix(r, A.w_o_b, D, 512, D, (bf16*)(ws + WS_WOB), nullptr, false, scr, lane); continue; } r -= I3;
        if (r < I4) { tr_matrix(r, A.w_out, D, D, D, (bf16*)(ws + WS_WOUT), nullptr, false, scr, lane); continue; } r -= I4;
        if (r < I5) { tr_matrix(r, A.w_up, FF, D, FF, (bf16*)(ws + WS_WUP), A.mlp_norm, false, scr, lane); continue; } r -= I5;
        if (r < I6) { tr_matrix(r, A.w_down, D, FF, D, (bf16*)(ws + WS_WDN), nullptr, false, scr, lane); continue; } r -= I6;
        if (r < I7) { tr_matrix(r, A.w_ple_gate, D, D, D, (bf16*)(ws + WS_WPG), A.ple_norm, false, scr, lane); continue; } r -= I7;
        tr_matrix(r, A.w_ple, D, PLE, D, (bf16*)(ws + WS_WPLE), nullptr, false, scr, lane);
    }
    bf16* XN = (bf16*)(ws + WS_XN); bf16* PB = (bf16*)(ws + WS_PBF);
    float* gbuf = (float*)(ws + WS_GB); float* bbuf = gbuf + (size_t)M * 4;
    f32x4 gn[4];
#pragma unroll
    for (int j = 0; j < 4; ++j) gn[j] = ((const f32x4*)A.attn_norm)[lane + 64 * j];
    f32x4 n1[4], n2[4], pn1, pn2;
    { const f32x4* xr = (const f32x4*)(A.x + (size_t)gw * D) + lane;
#pragma unroll
      for (int j = 0; j < 4; ++j) n1[j] = xr[64 * j];
      pn1 = ((const f32x4*)(A.p + (size_t)gw * PLE))[lane];
      const int m2 = (gw + NGW < M) ? gw + NGW : gw; const f32x4* xr2 = (const f32x4*)(A.x + (size_t)m2 * D) + lane;
#pragma unroll
      for (int j = 0; j < 4; ++j) n2[j] = xr2[64 * j];
      pn2 = ((const f32x4*)(A.p + (size_t)m2 * PLE))[lane]; }
    for (int m = gw; m < M; m += NGW) {
        {
        f32x4 vc[4]; const f32x4 pvc = pn1;
#pragma unroll
        for (int j = 0; j < 4; ++j) { vc[j] = n1[j]; n1[j] = n2[j]; }
        pn1 = pn2;
        { const int m3 = (m + 2 * NGW < M) ? m + 2 * NGW : m; const f32x4* xr3 = (const f32x4*)(A.x + (size_t)m3 * D) + lane;
#pragma unroll
          for (int j = 0; j < 4; ++j) n2[j] = xr3[64 * j];
          pn2 = ((const f32x4*)(A.p + (size_t)m3 * PLE))[lane]; }
        f32x4 v[4]; float s = 0.f;
#pragma unroll
        for (int j = 0; j < 4; ++j) { v[j] = vc[j]; s += (v[j].x * v[j].x + v[j].y * v[j].y) + (v[j].z * v[j].z + v[j].w * v[j].w); }
        const float rstd = rsqrtf(wave_sum(s) * (1.f / D) + EPS);
        float ab[8];
#pragma unroll
        for (int c = 0; c < 8; ++c) ab[c] = 0.f;
        unsigned long long* o8 = (unsigned long long*)(XN + (size_t)m * D) + lane;
#pragma unroll
        for (int j = 0; j < 4; ++j) { v[j] = v[j] * rstd * gn[j];
            o8[64 * j] = (unsigned long long)pk2(v[j].x, v[j].y) | ((unsigned long long)pk2(v[j].z, v[j].w) << 32);
#pragma unroll
            for (int c = 0; c < 8; ++c) { const f32x4 w4 = *(const LAS f32x4*)(Wab + c * 1024 + 256 * j + 4 * lane);
                ab[c] += (v[j].x * w4.x + v[j].y * w4.y) + (v[j].z * w4.z + v[j].w * w4.w); } }
        {
            const bool b0 = lane & 1, b1 = lane & 2, b2 = lane & 4;
            float w4[4], w2[2];
#pragma unroll
            for (int j = 0; j < 4; ++j) { const float send = b2 ? ab[j] : ab[j + 4], keep = b2 ? ab[j + 4] : ab[j]; w4[j] = keep + dpp_hmirror(send); }
#pragma unroll
            for (int j = 0; j < 2; ++j) { const float send = b1 ? w4[j] : w4[j + 2], keep = b1 ? w4[j + 2] : w4[j]; w2[j] = keep + dpp_xor2(send); }
            float tot; { const float send = b0 ? w2[0] : w2[1], keep = b0 ? w2[1] : w2[0]; tot = keep + dpp_xor1(send); }
            tot += dpp_ror8(tot); tot = xrow_sum(tot);
            const float partner = dpp_ror4(tot);
            if (lane < 4) { const int hd = lane;
                const float xx = tot + A.dt_bias[hd]; const float sp = xx > 20.f ? xx : log1pf(expf(xx));
                gbuf[(size_t)m * 4 + hd] = -expf(A.a_log[hd]) * sp;
                bbuf[(size_t)m * 4 + hd] = 1.0f / (1.0f + expf(-partner));
            }
        }
        const f32x4 pv = pvc;
        ((unsigned long long*)(PB + (size_t)m * PLE))[lane] = (unsigned long long)pk2(pv.x, pv.y) | ((unsigned long long)pk2(pv.z, pv.w) << 32);
        }
    }
}

__device__ __forceinline__ f32x4 mfma16(bf16x8 a, bf16x8 b, f32x4 c) { return __builtin_amdgcn_mfma_f32_16x16x32_bf16(a, b, c, 0, 0, 0); }
__device__ __forceinline__ f32x16 mfma32(bf16x8 a, bf16x8 b, f32x16 c) { return __builtin_amdgcn_mfma_f32_32x32x16_bf16(a, b, c, 0, 0, 0); }

template <int I> struct SolveRow {
    static __device__ __forceinline__ void run(float (&Tc)[64], const LAS float* Lf, int vz, float lanef) {
        SolveRow<I - 1>::run(Tc, Lf, vz, lanef);
        float a0 = fmaxf(1.0f - fabsf(lanef - (float)I), 0.0f), a1 = 0.f;
#pragma unroll
        for (int jj = 0; jj < (I + 3) / 4; ++jj) {
            const f32x4 l4 = *(const LAS f32x4*)(Lf + vz + I * 68 + 4 * jj);
            if (4 * jj + 0 < I) a0 -= l4.x * Tc[4 * jj + 0];
            if (4 * jj + 1 < I) a1 -= l4.y * Tc[4 * jj + 1];
            if (4 * jj + 2 < I) a0 -= l4.z * Tc[4 * jj + 2];
            if (4 * jj + 3 < I) a1 -= l4.w * Tc[4 * jj + 3];
        }
        Tc[I] = a0 + a1;
    }
};
template <> struct SolveRow<-1> { static __device__ __forceinline__ void run(float (&)[64], const LAS float*, int, float) {} };

#define GDN_LOAD_RAW(RAW_, CW_, GB_, unit_) do { const int bh_ = (unit_) >> 7, n_ = (unit_) & 127, b_ = bh_ >> 2, h_ = bh_ & 3; const size_t mm0 = (size_t)b_ * T + (size_t)n_ * 64; \
        const int ch_ = threadIdx.x & 127, tl0_ = 16 * (threadIdx.x >> 7), tseq_ = n_ * 64 + tl0_; \
        _Pragma("unroll") for (int s_ = 0; s_ < 3; ++s_) { const bf16* src_ = (const bf16*)(A.ws + WS_SEG) + (size_t)s_ * SEG + h_ * 128 + ch_; \
            _Pragma("unroll") for (int i_ = 0; i_ < 19; ++i_) RAW_[s_][i_] = (tseq_ - 3 + i_ >= 0) ? src_[(mm0 + tl0_ + i_ - 3) * 512] : (bf16)0; \
            _Pragma("unroll") for (int j_ = 0; j_ < 4; ++j_) CW_[s_][j_] = A.conv_w[j_ * 1536 + s_ * 512 + h_ * 128 + ch_]; } \
        GB_[0] = ((const float*)(A.ws + WS_GB))[(mm0 + (threadIdx.x & 63)) * 4 + h_]; GB_[1] = ((const float*)(A.ws + WS_GB) + (size_t)M * 4)[(mm0 + (threadIdx.x & 63)) * 4 + h_]; } while (0)
__device__ __forceinline__ void gdn_pre_unit(const Args& A, unsigned char* lds_g, int unit, bf16 (&raw)[3][19], float (&cw)[3][4], float (&gb)[2], int unit_next) {
    LAS unsigned char* lds = (LAS unsigned char*)lds_g;
    int tid_ = threadIdx.x; asm volatile("" : "+v"(tid_)); const int tid = tid_, lane = tid & 63, wave = __builtin_amdgcn_readfirstlane(tid >> 6);
    unsigned char* ws = A.ws;
    const int bh = unit >> 7, n = unit & 127, b = bh >> 2, h = bh & 3;
    const size_t m0 = (size_t)b * T + (size_t)n * 64;
    LAS bf16* Qb = (LAS bf16*)(lds);
    LAS bf16* Kb = (LAS bf16*)(lds + 17408);
    LAS bf16* VbT = (LAS bf16*)(lds + 34816);
    LAS bf16* KgT = (LAS bf16*)(lds + 53248);
    LAS float* Lf = (LAS float*)(lds + 71680);
    LAS bf16* Tb = (LAS bf16*)(lds + 89088);
    LAS float* Gs = (LAS float*)(lds + 98304);
    LAS float* Bs = Gs + 64; LAS float* SSQ = Gs + 128; LAS float* SSK = Gs + 192;
    const float* gbuf = (const float*)(ws + WS_GB); const float* bbuf = gbuf + (size_t)M * 4;
    const bf16* SG = (const bf16*)(ws + WS_SEG);
    bf16* qd = (bf16*)(ws + WS_XN) + (size_t)unit * 8192; bf16* kdT = (bf16*)(ws + WS_XN + 32 * MiB) + (size_t)unit * 8192;
    bf16* ub = (bf16*)((unsigned char*)A.out + DO_U) + (size_t)unit * 8192; bf16* wb = (bf16*)((unsigned char*)A.out + DO_W) + (size_t)unit * 8192;
    bf16* ab = (bf16*)((unsigned char*)A.out + DO_A) + (size_t)unit * 4096;
    float* egl = (float*)(ws + WS_CTL + 524288);
    if (wave == 0) {
        float gv = gb[0];
#pragma unroll
        for (int o = 1; o < 64; o <<= 1) { const float y = __shfl_up(gv, o); if (lane >= o) gv += y; }
        Gs[lane] = gv; Bs[lane] = gb[1]; SSQ[lane] = 0.f; SSK[lane] = 0.f;
        if (lane == 63) egl[(size_t)unit * 32] = __expf(gv);
    }
    LBAR();
    const int ch = tid & 127, tg = tid >> 7;
    float y[3][16];
#pragma unroll
    for (int s = 0; s < 3; ++s) {
        const int cidx = s * 512 + h * 128 + ch;
        const float w0 = cw[s][0], w1 = cw[s][1], w2 = cw[s][2], w3 = cw[s][3];
        float a0 = bf2f(raw[s][0]), a1 = bf2f(raw[s][1]), a2 = bf2f(raw[s][2]);
#pragma unroll
        for (int i = 0; i < 16; ++i) { const float a3 = bf2f(raw[s][3 + i]); y[s][i] = silu(w0 * a0 + w1 * a1 + w2 * a2 + w3 * a3); a0 = a1; a1 = a2; a2 = a3; }
    }
    if (unit_next < 2048) GDN_LOAD_RAW(raw, cw, gb, unit_next);
    {
        const bool b0 = lane & 1, b1 = lane & 2, b2 = lane & 4, b3 = lane & 8;
        float tot[2];
#pragma unroll
        for (int st = 0; st < 2; ++st) {
            float w8[8], w4[4], w2[2];
#pragma unroll
            for (int j = 0; j < 8; ++j) { const float lo = y[st][j] * y[st][j], hi = y[st][j + 8] * y[st][j + 8]; const float send = b3 ? lo : hi, keep = b3 ? hi : lo; w8[j] = keep + dpp_rmirror(send); }
#pragma unroll
            for (int j = 0; j < 4; ++j) { const float send = b2 ? w8[j] : w8[j + 4], keep = b2 ? w8[j + 4] : w8[j]; w4[j] = keep + dpp_hmirror(send); }
#pragma unroll
            for (int j = 0; j < 2; ++j) { const float send = b1 ? w4[j] : w4[j + 2], keep = b1 ? w4[j + 2] : w4[j]; w2[j] = keep + dpp_xor2(send); }
            { const float send = b0 ? w2[0] : w2[1], keep = b0 ? w2[1] : w2[0]; tot[st] = keep + dpp_xor1(send); }
            tot[st] = xrow_sum(tot[st]);
        }
        const int tok = lane & 15;
        if (lane < 16) { atomicAdd((float*)(SSQ + 16 * tg + tok), tot[0]); atomicAdd((float*)(SSK + 16 * tg + tok), tot[1]); }
    }
    LBAR();
    {
        const float g63 = Gs[63];
        unsigned vq[8], vk[8], vv[8], vd[8];
#pragma unroll
        for (int i = 0; i < 16; ++i) { const int tl = 16 * tg + i; const float rq = rsqrtf(SSQ[tl] + EPS), rk = rsqrtf(SSK[tl] + EPS), G = Gs[tl], be = Bs[tl], eG = __expf(G);
            const float qn = y[0][i] * rq, kn = y[1][i] * rk;
            Qb[tl * 136 + ch] = (bf16)f2bf(qn); Kb[tl * 136 + ch] = (bf16)f2bf(kn);
            const unsigned kg = f2bf(kn * be * eG), vb = f2bf(y[2][i] * be), kdv = f2bf(kn * __expf(g63 - G));
            if (i & 1) { vk[i >> 1] |= kg << 16; vv[i >> 1] |= vb << 16; vd[i >> 1] |= kdv << 16; } else { vk[i >> 1] = kg; vv[i >> 1] = vb; vd[i >> 1] = kdv; }
        }
        (void)vq;
        *(LAS v4u*)(KgT + ch * 72 + 16 * tg) = (v4u){vk[0], vk[1], vk[2], vk[3]}; *(LAS v4u*)(KgT + ch * 72 + 16 * tg + 8) = (v4u){vk[4], vk[5], vk[6], vk[7]};
        *(LAS v4u*)(VbT + ch * 72 + 16 * tg) = (v4u){vv[0], vv[1], vv[2], vv[3]}; *(LAS v4u*)(VbT + ch * 72 + 16 * tg + 8) = (v4u){vv[4], vv[5], vv[6], vv[7]};
        { const int blk = ch >> 4, rr_ = ch & 15, ks_ = tg >> 1, g0 = (2 * tg) & 3;
          *(v4u*)(kdT + (((blk * 2 + ks_) * 64 + g0 * 16 + rr_) << 3)) = (v4u){vd[0], vd[1], vd[2], vd[3]};
          *(v4u*)(kdT + (((blk * 2 + ks_) * 64 + (g0 + 1) * 16 + rr_) << 3)) = (v4u){vd[4], vd[5], vd[6], vd[7]}; }
    }
    LBAR();
    const int r = lane & 15, g = lane >> 4;
    {
#pragma unroll
        for (int pp = 0; pp < 2; ++pp) { const int p = tid + 512 * pp, frb = p >> 8, fks = (p >> 6) & 3, fl = p & 63, trow = 16 * frb + (fl & 15);
            const v4u qv = *(const LAS v4u*)(Qb + trow * 136 + 32 * fks + 8 * (fl >> 4)); const float sc = 0.08838834764831845f * __expf(Gs[trow]);
            v4u o; o.x = pk2(bflo(qv.x) * sc, bfhi(qv.x) * sc); o.y = pk2(bflo(qv.y) * sc, bfhi(qv.y) * sc); o.z = pk2(bflo(qv.z) * sc, bfhi(qv.z) * sc); o.w = pk2(bflo(qv.w) * sc, bfhi(qv.w) * sc);
            *(v4u*)(qd + ((size_t)p << 3)) = o; }
    }
    LAS bf16* Abuf = (LAS bf16*)(lds + 99328);
    {
        const int rb = wave & 3, which = wave >> 2;
        const LAS bf16* srcA = which ? Qb : Kb;
        bf16x8 af[4];
#pragma unroll
        for (int ks = 0; ks < 4; ++ks) af[ks] = *(const LAS bf16x8*)(srcA + (16 * rb + r) * 136 + 32 * ks + 8 * g);
#pragma unroll
        for (int cb = 0; cb < 4; ++cb) { f32x4 acc = {0.f, 0.f, 0.f, 0.f};
#pragma unroll
            for (int ks = 0; ks < 4; ++ks) { const bf16x8 bfr = *(const LAS bf16x8*)(Kb + (16 * cb + r) * 136 + 32 * ks + 8 * g); acc = mfma16(af[ks], bfr, acc); }
            const int s = 16 * cb + r; const float Gsv = Gs[s];
#pragma unroll
            for (int i = 0; i < 4; ++i) { const int c = 16 * rb + 4 * g + i; const float Gc = Gs[c];
                if (which == 0) { const float val = (s < c) ? Bs[c] * acc[i] * __expf(Gc - Gsv) : 0.f; Lf[c * 68 + s] = val; }
                else { const float val = (s <= c) ? 0.08838834764831845f * acc[i] * __expf(Gc - Gsv) : 0.f; Abuf[c * 72 + s] = (bf16)f2bf(val); } }
        }
    }
    LBAR();
    if (wave >= 4) {
#pragma unroll
        for (int pp = 0; pp < 2; ++pp) { const int p = (tid - 256) + 256 * pp, frb = p >> 7, fks = (p >> 6) & 1, fl = p & 63;
            *(v4u*)(ab + ((size_t)p << 3)) = *(const LAS v4u*)(Abuf + (16 * frb + (fl & 15)) * 72 + 32 * fks + 8 * (fl >> 4)); }
    }
    if (wave == 0) {
        float Tc[64]; int vz = 0; asm volatile("" : "+v"(vz));
        SolveRow<63>::run(Tc, Lf, vz, (float)lane);
#pragma unroll
        for (int i = 0; i < 64; ++i) Tb[i * 72 + lane] = (bf16)f2bf(Tc[i]);
    }
    LBAR();
    {
        const int rb = wave & 3, which = wave >> 2;
        const LAS bf16* srcB = which ? KgT : VbT; bf16* dst = which ? wb : ub;
        bf16x8 af[2];
#pragma unroll
        for (int ks = 0; ks < 2; ++ks) af[ks] = *(const LAS bf16x8*)(Tb + (16 * rb + r) * 72 + 32 * ks + 8 * g);
#pragma unroll
        for (int cb = 0; cb < 8; ++cb) { f32x4 acc = {0.f, 0.f, 0.f, 0.f};
#pragma unroll
            for (int ks = 0; ks < 2; ++ks) { const bf16x8 bfr = *(const LAS bf16x8*)(srcB + (16 * cb + r) * 72 + 32 * ks + 8 * g); acc = mfma16(af[ks], bfr, acc); }
            if (which == 0) { *(v2u*)(dst + (((rb * 8 + cb) * 64 + lane) << 2)) = (v2u){pk2(acc[0], acc[1]), pk2(acc[2], acc[3])}; }
            else {
#pragma unroll
            for (int i = 0; i < 4; ++i) { const int c_ = 16 * rb + 4 * g + i, k_ = 16 * cb + r;
                Qb[c_ * 136 + k_] = (bf16)f2bf(acc[i]); } }
        }
    }
    LBAR();
    {
#pragma unroll
        for (int pp = 0; pp < 2; ++pp) { const int p = tid + 512 * pp, frb = p >> 8, fks = (p >> 6) & 3, fl = p & 63;
            *(v4u*)(wb + ((size_t)p << 3)) = *(const LAS v4u*)(Qb + (16 * frb + (fl & 15)) * 136 + 32 * fks + 8 * (fl >> 4)); }
    }
    LBAR();
}

__device__ __forceinline__ void diff_prep_unit(const Args& A, unsigned char* lds_g, int mt) {
    LAS unsigned char* lds = (LAS unsigned char*)lds_g;
    int tid_ = threadIdx.x; asm volatile("" : "+v"(tid_)); const int tid = tid_, lane = tid & 63, wave = __builtin_amdgcn_readfirstlane(tid >> 6);
    unsigned char* ws = A.ws;
    bf16* SG = (bf16*)(ws + WS_SEG);
    const size_t m0 = (size_t)mt * 64;
    const float invf[8] = {1.0f, 0.1939227432012558f, 0.03760603070259094f, 0.007292664609849453f, 0.0014142135623842478f, 0.00027424818836152554f, 5.3182957344688475e-05f, 1.0313385246263351e-05f};
    const int dl = (lane & 7) * 8;
    float gq[8], gk[8];
#pragma unroll
    for (int e = 0; e < 8; ++e) { gq[e] = A.q_norm[dl + e]; gk[e] = A.k_norm[dl + e]; }
    v4u rawv[8][2]; int posv[8];
#pragma unroll
    for (int rr = 0; rr < 8; ++rr) { const size_t m = m0 + wave * 8 + rr; posv[rr] = A.pos[m];
        rawv[rr][0] = *(const v4u*)(SG + (size_t)4 * SEG + m * 512 + 8 * lane); rawv[rr][1] = *(const v4u*)(SG + (size_t)5 * SEG + m * 512 + 8 * lane); }
#pragma unroll
    for (int rr = 0; rr < 8; ++rr) {
        const size_t m = m0 + wave * 8 + rr;
        const float posf = (float)posv[rr];
        float cs[8], sn[8];
#pragma unroll
        for (int e = 0; e < 8; ++e) { const float ang = posf * invf[e]; const double ad = (double)ang; const double nn = __builtin_rint(ad * 0.15915494309189535); const float rr2 = (float)(ad - nn * 6.283185307179586);
            cs[e] = __cosf(rr2); sn[e] = __sinf(rr2); }
#pragma unroll
        for (int arr = 0; arr < 2; ++arr) {
            bf16* ptr = SG + (size_t)(4 + arr) * SEG + m * 512 + 8 * lane;
            const v4u raw = rawv[rr][arr];
            float v[8] = {bflo(raw.x), bfhi(raw.x), bflo(raw.y), bfhi(raw.y), bflo(raw.z), bfhi(raw.z), bflo(raw.w), bfhi(raw.w)};
            float ss = 0.f;
#pragma unroll
            for (int e = 0; e < 8; ++e) ss += v[e] * v[e];
            ss += dpp_xor1(ss); ss += dpp_xor2(ss); ss += dpp_hmirror(ss);
            const float rstd = rsqrtf(ss * (1.0f / 64.0f) + EPS);
#pragma unroll
            for (int e = 0; e < 8; ++e) v[e] = v[e] * rstd * (arr ? gk[e] : gq[e]);
            const int l7 = lane & 7;
#pragma unroll
            for (int e = 0; e < 8; ++e) { const float other = dpp_xor1(v[e]);
                if (l7 == 0) v[e] = v[e] * cs[e] - other * sn[e]; else if (l7 == 1) v[e] = v[e] * cs[e] + other * sn[e]; }
            const float sc = arr ? 1.0f : 0.125f * 1.4426950408889634f;
            v4u o; o.x = pk2(v[0] * sc, v[1] * sc); o.y = pk2(v[2] * sc, v[3] * sc); o.z = pk2(v[4] * sc, v[5] * sc); o.w = pk2(v[6] * sc, v[7] * sc);
            *(v4u*)ptr = o;
        }
    }
    LAS bf16* tile = (LAS bf16*)lds;
    const bf16* vsrc = SG + (size_t)6 * SEG + m0 * 512;
#pragma unroll
    for (int i = 0; i < 8; ++i) { const int id = tid + 512 * i, row = id >> 6, c16 = id & 63; *(LAS v4u*)(tile + row * 520 + c16 * 8) = *(const v4u*)(vsrc + (size_t)row * 512 + c16 * 8); }
    __syncthreads();
    {
        const int b = (int)(m0 / T), tt = (int)((m0 % T) / 64), hh = tid >> 7, d = tid & 127;
        bf16* dst = (bf16*)((unsigned char*)A.out + DO_VT) + (((size_t)(b * 4 + hh) * 128 + tt) * 128 + d) * 64;
#pragma unroll
        for (int c8 = 0; c8 < 8; ++c8) { unsigned w[4];
#pragma unroll
            for (int e = 0; e < 4; ++e) { const int q2 = 2 * e, kv = 16 * (c8 >> 1) + 8 * (q2 >> 2) + 4 * (c8 & 1) + (q2 & 3);
                const unsigned lo = tile[kv * 520 + tid], hi = tile[(kv + 1) * 520 + tid]; w[e] = lo | (hi << 16); }
            *(v4u*)(dst + c8 * 8) = (v4u){w[0], w[1], w[2], w[3]}; }
    }
    __syncthreads();
}

__device__ __forceinline__ void gdn_scan_item(const Args& A, unsigned char* lds_g, int bh) {
    LAS unsigned char* lds = (LAS unsigned char*)lds_g;
    int tid_ = threadIdx.x; asm volatile("" : "+v"(tid_)); const int tid = tid_, lane = tid & 63, wave = __builtin_amdgcn_readfirstlane(tid >> 6);
    unsigned char* ws = A.ws;
    const int r = lane & 15, g = lane >> 4, sl = wave, b = bh >> 2, h = bh & 3;
    LAS bf16* H1 = (LAS bf16*)lds;
    LAS bf16* H2 = (LAS bf16*)(lds + 32768);
    LAS bf16* ST = (LAS bf16*)(lds + 57344) + wave * 3328;
    LAS bf16* VN = ST + 2176;
    const v4u* qd4 = (const v4u*)((const bf16*)(ws + WS_XN) + (size_t)bh * 128 * 8192); const v4u* kd4 = (const v4u*)((const bf16*)(ws + WS_XN + 32 * MiB) + (size_t)bh * 128 * 8192);
    const v4u* wb4 = (const v4u*)((const bf16*)((unsigned char*)A.out + DO_W) + (size_t)bh * 128 * 8192); const v4u* ab4 = (const v4u*)((const bf16*)((unsigned char*)A.out + DO_A) + (size_t)bh * 128 * 4096);
    const bf16* ub = (const bf16*)((unsigned char*)A.out + DO_U) + (size_t)bh * 128 * 8192;
    const float* egl = (const float*)(ws + WS_CTL + 524288) + (size_t)bh * 128 * 32;
    float* oraw = (float*)(ws + WS_SEG) + ((size_t)b * T) * 512 + h * 128 + 16 * sl + r;
    f32x4 S[8];
#pragma unroll
    for (int k = 0; k < 8; ++k) { S[k] = (f32x4){0.f, 0.f, 0.f, 0.f}; *(LAS v2u*)(ST + r * 136 + 16 * k + 4 * g) = (v2u){0u, 0u}; }
    v4u sA[7], sB[7];
#define SCAN_LOADOPS(S_, i_) do { const size_t o1 = (size_t)(i_) * 1024, o2 = (size_t)(i_) * 512; \
        S_[0] = wb4[o1 + tid]; S_[1] = wb4[o1 + tid + 512]; S_[2] = qd4[o1 + tid]; S_[3] = qd4[o1 + tid + 512]; \
        S_[4] = ab4[o2 + tid]; S_[5] = kd4[o1 + tid]; S_[6] = kd4[o1 + tid + 512]; } while (0)
#define SCAN_WRITE_H1(S_) do { LAS v4u* p_ = (LAS v4u*)H1; p_[tid] = S_[0]; p_[tid + 512] = S_[1]; p_[1024 + tid] = S_[2]; p_[1536 + tid] = S_[3]; } while (0)
#define SCAN_WRITE_H2(S_) do { LAS v4u* p_ = (LAS v4u*)H2; p_[tid] = S_[4]; p_[512 + tid] = S_[5]; p_[1024 + tid] = S_[6]; } while (0)
    SCAN_LOADOPS(sA, 0); SCAN_WRITE_H1(sA); SCAN_WRITE_H2(sA);
    SCAN_LOADOPS(sB, 1);
    v2u uC[4], uN[4]; float eg = egl[0], egN = eg;
#pragma unroll
    for (int rb = 0; rb < 4; ++rb) uC[rb] = *(const v2u*)(ub + (((rb * 8 + sl) * 64 + lane) << 2));
    __syncthreads();
#define SCAN_STEP(i_, SNEXT_, SLOAD_) do { \
        if ((i_) + 2 < 128) SCAN_LOADOPS(SLOAD_, (i_) + 2); \
        { const int in_ = ((i_) + 1 < 128) ? (i_) + 1 : 127; \
          _Pragma("unroll") for (int rb = 0; rb < 4; ++rb) uN[rb] = *(const v2u*)(ub + (size_t)in_ * 8192 + (((rb * 8 + sl) * 64 + lane) << 2)); \
          egN = egl[(size_t)in_ * 32]; } \
        bf16x8 sb[4]; \
        _Pragma("unroll") for (int ks = 0; ks < 4; ++ks) sb[ks] = *(const LAS bf16x8*)(ST + r * 136 + 32 * ks + 8 * g); \
        f32x4 acc2[4]; \
        _Pragma("unroll") for (int rb = 0; rb < 4; ++rb) { \
            f32x4 acc1 = {0.f, 0.f, 0.f, 0.f}; acc2[rb] = (f32x4){0.f, 0.f, 0.f, 0.f}; \
            _Pragma("unroll") for (int ks = 0; ks < 4; ++ks) { \
                const bf16x8 wf = *(const LAS bf16x8*)(H1 + (((rb * 4 + ks) * 64 + lane) << 3)), qf = *(const LAS bf16x8*)(H1 + 8192 + (((rb * 4 + ks) * 64 + lane) << 3)); \
                acc1 = mfma16(wf, sb[ks], acc1); acc2[rb] = mfma16(qf, sb[ks], acc2[rb]); } \
            const float v0 = bflo(uC[rb].x) - acc1[0], v1 = bfhi(uC[rb].x) - acc1[1], v2 = bflo(uC[rb].y) - acc1[2], v3 = bfhi(uC[rb].y) - acc1[3]; \
            *(LAS v2u*)(VN + r * 72 + 16 * rb + 4 * g) = (v2u){pk2(v0, v1), pk2(v2, v3)}; } \
        LBAR(); \
        if ((i_) + 1 < 128) SCAN_WRITE_H1(SNEXT_); \
        bf16x8 vb[2]; \
        _Pragma("unroll") for (int ks = 0; ks < 2; ++ks) vb[ks] = *(const LAS bf16x8*)(VN + r * 72 + 32 * ks + 8 * g); \
        _Pragma("unroll") for (int rb = 0; rb < 4; ++rb) { \
            _Pragma("unroll") for (int ks = 0; ks < 2; ++ks) { const bf16x8 af = *(const LAS bf16x8*)(H2 + (((rb * 2 + ks) * 64 + lane) << 3)); acc2[rb] = mfma16(af, vb[ks], acc2[rb]); } \
            float* op = oraw + ((size_t)(i_) * 64 + 16 * rb + 4 * g) * 512; \
            op[0] = acc2[rb][0]; op[512] = acc2[rb][1]; op[1024] = acc2[rb][2]; op[1536] = acc2[rb][3]; } \
        _Pragma("unroll") for (int k = 0; k < 8; ++k) { S[k] = S[k] * eg; \
            _Pragma("unroll") for (int ks = 0; ks < 2; ++ks) { const bf16x8 kf = *(const LAS bf16x8*)(H2 + 4096 + (((k * 2 + ks) * 64 + lane) << 3)); S[k] = mfma16(kf, vb[ks], S[k]); } \
            *(LAS v2u*)(ST + r * 136 + 16 * k + 4 * g) = (v2u){pk2(S[k][0], S[k][1]), pk2(S[k][2], S[k][3])}; } \
        LBAR(); \
        if ((i_) + 1 < 128) SCAN_WRITE_H2(SNEXT_); \
        _Pragma("unroll") for (int rb = 0; rb < 4; ++rb) uC[rb] = uN[rb]; \
        eg = egN; \
    } while (0)
    for (int i = 0; i < 128; i += 2) { SCAN_STEP(i, sB, sA); SCAN_STEP(i + 1, sA, sB); }
    __syncthreads();
#undef SCAN_STEP
#undef SCAN_LOADOPS
#undef SCAN_WRITE_H1
#undef SCAN_WRITE_H2
}

__device__ __forceinline__ void attn_unit(const Args& A, unsigned char* lds_g, int bh, int qb, float negshift, float lam) {
    LAS unsigned char* lds = (LAS unsigned char*)lds_g;
    int tid_ = threadIdx.x; asm volatile("" : "+v"(tid_)); const int tid = tid_, lane = tid & 63, wave = __builtin_amdgcn_readfirstlane(tid >> 6);
    unsigned char* ws = A.ws;
    const int r = lane & 31, hh = lane >> 5, comp = wave >> 2, w4 = wave & 3;
    const int b = bh >> 2, h = bh & 3;
    const size_t rowbase = (size_t)b * T; const int q0 = qb * 128;
    const bf16* DQ = (const bf16*)(ws + WS_SEG) + (size_t)4 * SEG; const bf16* DK = (const bf16*)(ws + WS_SEG) + (size_t)5 * SEG;
    const bf16* VT = (const bf16*)((unsigned char*)A.out + DO_VT) + (size_t)bh * 128 * 8192;
    bf16* OB = (bf16*)(ws + WS_SEG) + (size_t)6 * SEG;
    LAS bf16* Ks = (LAS bf16*)lds;
    LAS bf16* Vs = (LAS bf16*)(lds + 34816);
    LAS bf16* Qs = (LAS bf16*)(lds + 90112);
#pragma unroll
    for (int i = 0; i < 4; ++i) { const int id = tid + 512 * i, qrow = id >> 4, qch = id & 15;
        *(LAS v4u*)(Qs + qrow * 136 + qch * 8) = *(const v4u*)(DQ + (rowbase + q0 + qrow) * 512 + h * 128 + qch * 8); }
    const LAS bf16* qfp = Qs + (32 * w4 + r) * 136 + comp * 64 + 8 * hh;
    f32x16 o[4];
#pragma unroll
    for (int d = 0; d < 4; ++d)
#pragma unroll
        for (int i = 0; i < 16; ++i) o[d][i] = 0.f;
    float lsum = 0.f;
    const int nt = 2 * (qb + 1);
    const int id0 = tid, id1 = tid + 512;
    const bf16* ksrc0 = DK + (rowbase + (id0 >> 4)) * 512 + h * 128 + (id0 & 15) * 8; const bf16* ksrc1 = DK + (rowbase + (id1 >> 4)) * 512 + h * 128 + (id1 & 15) * 8;
    const int kdst0 = (id0 >> 4) * 136 + (id0 & 15) * 8, kdst1 = (id1 >> 4) * 136 + (id1 & 15) * 8;
    const int vdst0 = (id0 >> 3) * 72 + (id0 & 7) * 8, vdst1 = (id1 >> 3) * 72 + (id1 & 7) * 8;
    v4u kr0, kr1, vr0, vr1;
#define ATT_LOADK(S_, t_) do { kr0 = *(const v4u*)(ksrc0 + (size_t)(t_) * 64 * 512); kr1 = *(const v4u*)(ksrc1 + (size_t)(t_) * 64 * 512); } while (0)
#define ATT_LOADV(t_) do { vr0 = *(const v4u*)(VT + (size_t)(t_) * 8192 + id0 * 8); vr1 = *(const v4u*)(VT + (size_t)(t_) * 8192 + id1 * 8); } while (0)
#define ATT_WRITE(S_, kbuf_, voff_) do { LAS bf16* kb_ = Ks + (kbuf_) * (64 * 136); LAS bf16* vb_ = Vs + (voff_); \
        *(LAS v4u*)(kb_ + kdst0) = kr0; *(LAS v4u*)(kb_ + kdst1) = kr1; \
        *(LAS v4u*)(vb_ + vdst0) = vr0; *(LAS v4u*)(vb_ + vdst1) = vr1; } while (0)
    ATT_LOADK(A, 0); ATT_LOADV(0); ATT_WRITE(A, 0, 0);
    __syncthreads();
    const int qrel = 32 * w4 + r;
    constexpr int VSZ = 128 * 72;
    int vcur = 0, vprev = 2 * VSZ, vnext = VSZ;
    bf16x8 pbp[2][2];
#pragma unroll
    for (int a = 0; a < 2; ++a)
#pragma unroll
        for (int b2 = 0; b2 < 2; ++b2) pbp[a][b2] = (bf16x8){0, 0, 0, 0, 0, 0, 0, 0};
    for (int e = tid; e < VSZ / 8; e += 512) *(LAS v4u*)(Vs + 2 * VSZ + e * 8) = (v4u){0u, 0u, 0u, 0u};
    __syncthreads();
#define ATT_VFRAGP(d_, kb_, s_) (*(const LAS bf16x8*)(Vp + (32 * (d_) + r) * 72 + 32 * (kb_) + 16 * (s_) + 8 * hh))
#define ATT_EXP8(P_, S2_, KB_, BANDED, DST_) do { \
        _Pragma("unroll") for (int i = 8 * (S2_); i < 8 * (S2_) + 8; ++i) { float e = __builtin_amdgcn_exp2f(P_[i]); \
            if (BANDED) { const int kvrel = 64 * band + 32 * (KB_) + (i & 3) + 8 * (i >> 2) + 4 * hh; if (kvrel > qrel) e = 0.f; } \
            P_[i] = e; lsum += e; } \
        { v4u w; w.x = pk2(P_[8 * (S2_) + 0], P_[8 * (S2_) + 1]); w.y = pk2(P_[8 * (S2_) + 2], P_[8 * (S2_) + 3]); \
            w.z = pk2(P_[8 * (S2_) + 4], P_[8 * (S2_) + 5]); w.w = pk2(P_[8 * (S2_) + 6], P_[8 * (S2_) + 7]); DST_ = __builtin_bit_cast(bf16x8, w); } \
    } while (0)
#define ATT_TILE(BANDED, PAR_, LOADS_, WRITES_) do { \
        LOADS_; \
        const LAS bf16* Kb = Ks + (PAR_) * (64 * 136); const LAS bf16* Vp = Vs + vprev; \
        const int band = t - (nt - 2); \
        bf16x8 kf[2][4], qf[4]; \
        _Pragma("unroll") for (int kb = 0; kb < 2; ++kb) _Pragma("unroll") for (int ks = 0; ks < 4; ++ks) kf[kb][ks] = *(const LAS bf16x8*)(Kb + (32 * kb + r) * 136 + comp * 64 + 16 * ks + 8 * hh); \
        _Pragma("unroll") for (int ks = 0; ks < 4; ++ks) qf[ks] = *(const LAS bf16x8*)(qfp + 16 * ks); \
        __builtin_amdgcn_sched_barrier(0); \
        f32x16 p0, p1; \
        _Pragma("unroll") for (int i = 0; i < 16; ++i) { p0[i] = negshift; p1[i] = negshift; } \
        _Pragma("unroll") for (int ks = 0; ks < 4; ++ks) p0 = mfma32(kf[0][ks], qf[ks], p0); \
        _Pragma("unroll") for (int ks = 0; ks < 4; ++ks) p1 = mfma32(kf[1][ks], qf[ks], p1); \
        bf16x8 vfa[8]; \
        _Pragma("unroll") for (int d = 0; d < 4; ++d) _Pragma("unroll") for (int s2 = 0; s2 < 2; ++s2) vfa[d * 2 + s2] = ATT_VFRAGP(d, 0, s2); \
        __builtin_amdgcn_sched_barrier(0); \
        bf16x8 pbn[2][2]; \
          \
        _Pragma("unroll") for (int d = 0; d < 4; ++d) o[d] = mfma32(vfa[d * 2 + 0], pbp[0][0], o[d]); \
        ATT_EXP8(p0, 0, 0, BANDED, pbn[0][0]); \
        _Pragma("unroll") for (int d = 0; d < 4; ++d) o[d] = mfma32(vfa[d * 2 + 1], pbp[0][1], o[d]); \
        ATT_EXP8(p0, 1, 0, BANDED, pbn[0][1]); \
        bf16x8 vfb[8]; \
        _Pragma("unroll") for (int d = 0; d < 4; ++d) _Pragma("unroll") for (int s2 = 0; s2 < 2; ++s2) vfb[d * 2 + s2] = ATT_VFRAGP(d, 1, s2); \
        __builtin_amdgcn_sched_barrier(0); \
        _Pragma("unroll") for (int d = 0; d < 4; ++d) o[d] = mfma32(vfb[d * 2 + 0], pbp[1][0], o[d]); \
        ATT_EXP8(p1, 0, 1, BANDED, pbn[1][0]); \
        _Pragma("unroll") for (int d = 0; d < 4; ++d) o[d] = mfma32(vfb[d * 2 + 1], pbp[1][1], o[d]); \
        ATT_EXP8(p1, 1, 1, BANDED, pbn[1][1]); \
        __builtin_amdgcn_sched_barrier(0); \
        _Pragma("unroll") for (int a = 0; a < 2; ++a) _Pragma("unroll") for (int b2 = 0; b2 < 2; ++b2) pbp[a][b2] = pbn[a][b2]; \
        WRITES_; \
        { const int tmp = vprev; vprev = vcur; vcur = vnext; vnext = tmp; } \
        __syncthreads(); \
    } while (0)
    int t = 0;
    for (; t < nt - 2; t += 2) {
        ATT_TILE(false, 0, { ATT_LOADK(A, t + 1); ATT_LOADV(t + 1); }, ATT_WRITE(B, 1, vnext));
        ++t; ATT_TILE(false, 1, { ATT_LOADK(B, t + 1); ATT_LOADV(t + 1); }, ATT_WRITE(A, 0, vnext)); --t;
    }
    ATT_TILE(true, 0, { ATT_LOADK(A, t + 1); ATT_LOADV(t + 1); }, ATT_WRITE(B, 1, vnext)); ++t;
    ATT_TILE(true, 1, (void)0, (void)0);
    {
        const LAS bf16* Vp = Vs + vprev;
#pragma unroll
        for (int kb = 0; kb < 2; ++kb)
#pragma unroll
            for (int s2 = 0; s2 < 2; ++s2)
#pragma unroll
                for (int d = 0; d < 4; ++d) o[d] = mfma32(ATT_VFRAGP(d, kb, s2), pbp[kb][s2], o[d]);
    }
    __syncthreads();
#undef ATT_TILE
#undef ATT_EXP8
#undef ATT_VFRAGP
#undef ATT_LOADK
#undef ATT_LOADV
#undef ATT_WRITE
    lsum += __shfl_xor(lsum, 32);
    const float inv = 1.0f / lsum;
    LAS float* X = (LAS float*)lds;
    if (comp == 1) {
#pragma unroll
        for (int d = 0; d < 4; ++d)
#pragma unroll
            for (int i = 0; i < 16; ++i) X[(w4 * 64 + d * 16 + i) * 64 + lane] = o[d][i] * inv;
    }
    __syncthreads();
    if (comp == 0) {
        float ss = 0.f;
#pragma unroll
        for (int d = 0; d < 4; ++d)
#pragma unroll
            for (int i = 0; i < 16; ++i) { const float v = o[d][i] * inv - lam * X[(w4 * 64 + d * 16 + i) * 64 + lane]; o[d][i] = v; ss += v * v; }
        ss += __shfl_xor(ss, 32);
        const float rstd = rsqrtf(ss * (1.0f / 128.0f) + EPS) * 0.8f;
        bf16* orow = OB + (rowbase + q0 + 32 * w4 + r) * 512 + h * 128;
#pragma unroll
        for (int d = 0; d < 4; ++d)
#pragma unroll
            for (int g4 = 0; g4 < 4; ++g4) { const int dd = 32 * d + 8 * g4 + 4 * hh; const f32x4 gn = *(const f32x4*)(A.diff_norm + dd);
                v2u w; w.x = pk2(o[d][4 * g4 + 0] * rstd * gn.x, o[d][4 * g4 + 1] * rstd * gn.y); w.y = pk2(o[d][4 * g4 + 2] * rstd * gn.z, o[d][4 * g4 + 3] * rstd * gn.w);
                *(v2u*)(orow + dd) = w; }
    }
    __syncthreads();
}

__device__ __forceinline__ void p4_post(const Args& A) {
    int tid_ = threadIdx.x; asm volatile("" : "+v"(tid_)); const int tid = tid_, lane = tid & 63, wave = tid >> 6;
    unsigned char* ws = A.ws;
    const float* oraw = (const float*)(ws + WS_SEG); const bf16* Z = (const bf16*)(ws + WS_SEG) + (size_t)3 * SEG; bf16* OA = (bf16*)(ws + WS_SEG) + (size_t)2 * SEG;
    const int gw = blockIdx.x * 8 + wave, NGW = gridDim.x * 8;
    const int d0 = (lane & 15) * 8;
    float gn[8];
#pragma unroll
    for (int e = 0; e < 8; ++e) gn[e] = A.gdn_norm[d0 + e];
    for (int m0r = gw; m0r < M; m0r += 4 * NGW) {
        f32x4 a0v[4], a1v[4]; v4u zv[4];
#pragma unroll
        for (int q4 = 0; q4 < 4; ++q4) { const int m = m0r + q4 * NGW; a0v[q4] = *(const f32x4*)(oraw + (size_t)m * 512 + 8 * lane); a1v[q4] = *(const f32x4*)(oraw + (size_t)m * 512 + 8 * lane + 4); zv[q4] = *(const v4u*)(Z + (size_t)m * 512 + 8 * lane); }
#pragma unroll
        for (int q4 = 0; q4 < 4; ++q4) { const int m = m0r + q4 * NGW; const f32x4 a0 = a0v[q4], a1 = a1v[q4];
        float v[8] = {a0.x, a0.y, a0.z, a0.w, a1.x, a1.y, a1.z, a1.w};
        float ss = 0.f;
#pragma unroll
        for (int e = 0; e < 8; ++e) ss += v[e] * v[e];
        ss += dpp_xor1(ss); ss += dpp_xor2(ss); ss += dpp_hmirror(ss); ss += dpp_rmirror(ss);
        const float rstd = rsqrtf(ss * (1.0f / 128.0f) + EPS);
        const v4u zr = zv[q4];
        const float z[8] = {bflo(zr.x), bfhi(zr.x), bflo(zr.y), bfhi(zr.y), bflo(zr.z), bfhi(zr.z), bflo(zr.w), bfhi(zr.w)};
#pragma unroll
        for (int e = 0; e < 8; ++e) v[e] = v[e] * rstd * gn[e] * silu(z[e]);
        v4u o; o.x = pk2(v[0], v[1]); o.y = pk2(v[2], v[3]); o.z = pk2(v[4], v[5]); o.w = pk2(v[6], v[7]);
        *(v4u*)(OA + (size_t)m * 512 + 8 * lane) = o;
        }
    }
}

#define XB_TMO      128
#define XB_XCNT(j)  (256  + 64 * (j))
#define XB_XSUB(j)  (1280 + 64 * (j))
#define XB_XGEN(j)  (2304 + 64 * (j))
#define XB_TOP      3328
#define XB_TOPGEN   3392
#define XCD_BAR_WORDS 3456
#define XB_SPIN_CAP (1u << 18)

__device__ __forceinline__ unsigned xb_ld(unsigned* p)              { return __hip_atomic_load(p, __ATOMIC_RELAXED, __HIP_MEMORY_SCOPE_AGENT); }
__device__ __forceinline__ unsigned xb_add(unsigned* p, unsigned v) { return __hip_atomic_fetch_add(p, v, __ATOMIC_RELAXED, __HIP_MEMORY_SCOPE_AGENT); }
__device__ __forceinline__ unsigned xb_xcc_id() { return (unsigned)__builtin_amdgcn_s_getreg((3 << 11) | 20) & 0xFu; }
#define XB_SPIN(cond, bar) do { unsigned _sp = 0; while (cond) { __builtin_amdgcn_s_sleep(1); \
    if ((++_sp & 255u) == 0u) { if (xb_ld(&(bar)[XB_TMO])) break; if (_sp > XB_SPIN_CAP) { atomicAdd(&(bar)[XB_TMO], 1u); break; } } } } while (0)

struct XcdBarrier {
    unsigned* bar; unsigned x;
    volatile LAS unsigned* st;
};

__device__ __forceinline__ XcdBarrier xcd_barrier_post(unsigned* bar, volatile LAS unsigned* st) {
    XcdBarrier b; b.bar = bar; b.x = xb_xcc_id(); b.st = st;
    if (threadIdx.x == 0) (void)xb_add(&bar[XB_XCNT(b.x)], 1u);
    return b;
}
__device__ __forceinline__ void xcd_barrier_complete(unsigned* bar, unsigned x, unsigned& nloc, unsigned& nx) {
    const unsigned G = gridDim.x * gridDim.y * gridDim.z;
    unsigned sum, cnt, mine, sp = 0u;
    for (;;) {
        sum = 0u; cnt = 0u; mine = 0u;
#pragma unroll
        for (unsigned j = 0; j < 16; ++j) { const unsigned c = xb_ld(&bar[XB_XCNT(j)]); sum += c; cnt += (c > 0u) ? 1u : 0u; mine = (j == x) ? c : mine; }
        if (sum == G) break;
        __builtin_amdgcn_s_sleep(1);
        if ((++sp & 255u) == 0u) { if (xb_ld(&bar[XB_TMO])) break; if (sp > XB_SPIN_CAP) { atomicAdd(&bar[XB_TMO], 1u); break; } }
    }
    nloc = mine > 0u ? mine : 1u; nx = cnt > 0u ? cnt : 1u;
}

__device__ __forceinline__ void xcd_barrier(const XcdBarrier& b) {
    asm volatile("s_waitcnt vmcnt(0)" ::: "memory");
    __syncthreads();
    if (threadIdx.x == 0) {
        unsigned* bar = b.bar;
        __builtin_amdgcn_s_waitcnt(0);
        unsigned nloc = b.st[0], nx = b.st[1];
        if (nloc == 0u) { xcd_barrier_complete(bar, b.x, nloc, nx); b.st[0] = nloc; b.st[1] = nx; }
        const unsigned old = xb_add(&bar[XB_XSUB(b.x)], 1u);
        const unsigned gen = old / nloc;
        if (old + 1u == (gen + 1u) * nloc) {
            __builtin_amdgcn_fence(__ATOMIC_RELEASE, "agent");
            asm volatile("s_waitcnt vmcnt(0)" ::: "memory");
            const unsigned og = xb_add(&bar[XB_TOP], 1u);
            const unsigned tg = og / nx;
            if (og + 1u == (tg + 1u) * nx) xb_add(&bar[XB_TOPGEN], 1u);
            else XB_SPIN(xb_ld(&bar[XB_TOPGEN]) == tg, bar);
            __builtin_amdgcn_fence(__ATOMIC_ACQUIRE, "agent");
            xb_add(&bar[XB_XGEN(b.x)], 1u);
            asm volatile("s_waitcnt vmcnt(0)" ::: "memory");
        } else {
            XB_SPIN(xb_ld(&bar[XB_XGEN(b.x)]) == gen, bar);
            __builtin_amdgcn_fence(__ATOMIC_ACQUIRE, "agent");
            asm volatile("s_waitcnt vmcnt(0)" ::: "memory");
        }
    }
    __syncthreads();
}

__global__ void __launch_bounds__(512, 2) mega_fwd(Args A) {
    extern __shared__ __attribute__((aligned(16))) unsigned char lds[];
    cg::grid_group grid = cg::this_grid();
    const int tid = threadIdx.x;
    unsigned char* ws = A.ws;
    PG8_LAS unsigned char* glds = (PG8_LAS unsigned char*)lds;
    bf16* SG = (bf16*)(ws + WS_SEG);
    float* ss2 = (float*)(ws + WS_CTL + 65536); float* ss3 = (float*)(ws + WS_CTL + 262144);
    const int G = gridDim.x, c = blockIdx.x;

    if (tid == 0) { ((volatile LAS unsigned*)((LAS unsigned char*)lds + LDS_MISC))[8] = 0u; ((volatile LAS unsigned*)((LAS unsigned char*)lds + LDS_MISC))[9] = 0u; }
    __syncthreads();
    const XcdBarrier xbar = xcd_barrier_post((unsigned*)(ws + WS_BAR), (volatile LAS unsigned*)((LAS unsigned char*)lds + LDS_MISC) + 8);
#ifndef NO_P0
    p0_prologue(A, lds);
#ifdef DBL_P0
    __syncthreads();
    p0_prologue(A, lds);
#endif
#endif
    xcd_barrier(xbar);
    if (ws == nullptr) grid.sync();
#define GSYNC() xcd_barrier(xbar)
    { pg8::Gemm g{(const bf16*)(ws + WS_XN), (const bf16*)(ws + WS_WIN), M, NP, D}; pg8::StaticOrder S; S.init(M, NP, G, c);
      pg8::EpiSplit E{SG}; pg8::gemm_phase<pg8::EpiSplit, pg8::StaticOrder, true, true>(glds, g, S, E);
#ifdef DBL_G15
      pg8::gemm_phase<pg8::EpiSplit, pg8::StaticOrder, true, true>(glds, g, S, E);
#endif
    }
    GSYNC();
#ifdef DBG_FILL
    { v4u z = (v4u){0u,0u,0u,0u};
      v4u* p1 = (v4u*)(ws + WS_XN); for (size_t i = (size_t)c * 512 + tid; i < (64 * MiB) / 16; i += (size_t)G * 512) p1[i] = z;
      v4u* p2 = (v4u*)A.out; for (size_t i = (size_t)c * 512 + tid; i < (128 * MiB) / 16; i += (size_t)G * 512) p2[i] = z; }
    GSYNC();
#endif
    bf16 rawp[3][19]; float cwp[3][4], gbp[2];
    if (c < 2048) GDN_LOAD_RAW(rawp, cwp, gbp, c);
    for (int u = c; u < 2048 + 512; u += G) {
#ifndef NO_P2A
        if (u < 2048) gdn_pre_unit(A, lds, u, rawp, cwp, gbp, u + G);
#endif
#ifndef NO_P2B
        if (u >= 2048) diff_prep_unit(A, lds, u - 2048);
#endif
    }
    GSYNC();
#ifndef NO_P3
    {
        float mq = fabsf(A.q_norm[tid & 63]), mk = fabsf(A.k_norm[tid & 63]);
        float l1 = A.lq1[tid & 63] * A.lk1[tid & 63], l2 = A.lq2[tid & 63] * A.lk2[tid & 63];
#pragma unroll
        for (int o = 1; o < 64; o <<= 1) { mq = fmaxf(mq, __shfl_xor(mq, o)); mk = fmaxf(mk, __shfl_xor(mk, o)); l1 += __shfl_xor(l1, o); l2 += __shfl_xor(l2, o); }
        const float negshift = -(8.0f * mq * mk * 1.4426950408889634f + 0.5f);
        const float lam = expf(l1) - expf(l2) + 0.2f;
        LAS unsigned* misc = (LAS unsigned*)((LAS unsigned char*)lds + LDS_MISC);
        unsigned* qctr = (unsigned*)(ws + WS_CTL);
        for (;;) {
            if (tid == 0) misc[0] = atomicAdd(qctr, 1u);
            __syncthreads();
            const int it = (int)misc[0];
            __syncthreads();
            if (it >= NQ_GDN + NQ_ATT) break;
            if (it < NQ_GDN) gdn_scan_item(A, lds, it);
            else { const int j = it - NQ_GDN; attn_unit(A, lds, j & 15, 63 - (j >> 4), negshift, lam); }
        }
    }
#endif
    GSYNC();
#ifdef DBG_P2A_DIGEST
    { const bf16* qd = (const bf16*)(ws + WS_XN); const bf16* kd = (const bf16*)(ws + WS_XN + 32 * MiB);
      const bf16* ub = (const bf16*)((unsigned char*)A.out + DO_U); const bf16* wb = (const bf16*)((unsigned char*)A.out + DO_W); const bf16* ab = (const bf16*)((unsigned char*)A.out + DO_A);
      const float* eg = (const float*)(ws + WS_CTL + 524288);
      bf16* OA = SG + 2 * SEG;
      for (size_t i = (size_t)c * 512 + tid; i < SEG; i += (size_t)G * 512) {
          float v = bf2f(qd[i]) + bf2f(kd[i]) + bf2f(ub[i]) + bf2f(wb[i]) + bf2f(ab[i >> 1]) + eg[(i & 2047) * 32];
          OA[i] = (bf16)f2bf(v); } }
#endif
#ifndef NO_P4
    p4_post(A);
#endif
    GSYNC();
    { pg8::StaticOrder S; S.init(M, D, G, c);
      { pg8::Gemm g{SG + 2 * SEG, (const bf16*)(ws + WS_WOA), M, D, 512}; pg8::EpiGate<false> E{SG + 7 * SEG, (bf16*)(ws + WS_XN)};
        pg8::gemm_phase<pg8::EpiGate<false>, pg8::StaticOrder, true, true>(glds, g, S, E); }
      { pg8::Gemm g{SG + 6 * SEG, (const bf16*)(ws + WS_WOB), M, D, 512}; pg8::EpiGate<true> E{SG + 9 * SEG, (bf16*)(ws + WS_XN)};
        pg8::gemm_phase<pg8::EpiGate<true>, pg8::StaticOrder, true, true>(glds, g, S, E); } }
    GSYNC();
    { pg8::Gemm g{(const bf16*)(ws + WS_XN), (const bf16*)(ws + WS_WOUT), M, D, D}; pg8::StaticOrder S; S.init(M, D, G, c);
      pg8::EpiResB<false> E{A.x, SG + 8 * SEG, ss2}; pg8::gemm_phase<pg8::EpiResB<false>, pg8::StaticOrder, true, true>(glds, g, S, E); }
    GSYNC();
    { pg8::Gemm g{SG + 8 * SEG, (const bf16*)(ws + WS_WUP), M, FF, D}; pg8::StaticOrder S; S.init(M, FF, G, c);
      pg8::EpiUp E{SG, ss2}; pg8::gemm_phase<pg8::EpiUp, pg8::StaticOrder, true, true>(glds, g, S, E);
#ifdef DBL_G15
      pg8::gemm_phase<pg8::EpiUp, pg8::StaticOrder, true, true>(glds, g, S, E);
#endif
    }
    GSYNC();
    { pg8::Gemm g{SG, (const bf16*)(ws + WS_WDN), M, D, FF}; pg8::StaticOrder S; S.init(M, D, G, c);
      pg8::EpiResB<true> E{SG + 8 * SEG, (bf16*)(ws + WS_XN), ss3}; pg8::gemm_phase<pg8::EpiResB<true>, pg8::StaticOrder, true, true>(glds, g, S, E); }
    GSYNC();
    { pg8::StaticOrder S; S.init(M, D, G, c);
      { pg8::Gemm g{(const bf16*)(ws + WS_PBF), (const bf16*)(ws + WS_WPLE), M, D, PLE}; pg8::EpiBf E{SG};
        pg8::gemm_phase<pg8::EpiBf, pg8::StaticOrder, true, true>(glds, g, S, E); }
      { pg8::Gemm g{(const bf16*)(ws + WS_XN), (const bf16*)(ws + WS_WPG), M, D, D}; pg8::EpiPleB E{A.out, (const bf16*)(ws + WS_XN), SG, ss3};
        pg8::gemm_phase<pg8::EpiPleB, pg8::StaticOrder, true, true>(glds, g, S, E); } }
}

extern "C" void kernel_launch(void* const* d_in, const int* in_sizes, int n_in, void* d_out, int out_size, void* d_ws, size_t ws_size, hipStream_t stream) {
    static int grid = 0;
    if (grid == 0) {
        if (n_in != 25 || ws_size < WS_END || out_size != M * D) { fprintf(stderr, "kernel_launch: unexpected shapes (n_in %d, ws %zu, out %d)\n", n_in, ws_size, out_size); grid = -1; return; }
        int dev = 0, cus = 0, per_cu = 0;
        hipGetDevice(&dev); hipDeviceGetAttribute(&cus, hipDeviceAttributeMultiprocessorCount, dev);
        hipFuncSetAttribute((const void*)mega_fwd, hipFuncAttributeMaxDynamicSharedMemorySize, LDS_BYTES);
        hipOccupancyMaxActiveBlocksPerMultiprocessor(&per_cu, (const void*)mega_fwd, 512, LDS_BYTES);
        (void)hipGetLastError();
        if (per_cu < 1) per_cu = 1;
        grid = cus * 1;
    }
    if (grid < 0) return;
    Args a{};
    a.x = (const float*)d_in[0]; a.p = (const float*)d_in[1]; a.pos = (const int*)d_in[2]; a.attn_norm = (const float*)d_in[3]; a.w_in = (const float*)d_in[4];
    a.conv_w = (const float*)d_in[5]; a.a_log = (const float*)d_in[6]; a.dt_bias = (const float*)d_in[7]; a.gdn_norm = (const float*)d_in[8]; a.w_o_a = (const float*)d_in[9];
    a.q_norm = (const float*)d_in[10]; a.k_norm = (const float*)d_in[11]; a.lq1 = (const float*)d_in[12]; a.lk1 = (const float*)d_in[13]; a.lq2 = (const float*)d_in[14]; a.lk2 = (const float*)d_in[15];
    a.diff_norm = (const float*)d_in[16]; a.w_o_b = (const float*)d_in[17]; a.w_out = (const float*)d_in[18]; a.mlp_norm = (const float*)d_in[19]; a.w_up = (const float*)d_in[20];
    a.w_down = (const float*)d_in[21]; a.ple_norm = (const float*)d_in[22]; a.w_ple_gate = (const float*)d_in[23]; a.w_ple = (const float*)d_in[24];
    a.out = (float*)d_out; a.ws = (unsigned char*)d_ws;
    (void)hipMemsetAsync(d_ws, 0, 1 * MiB, stream);
    void* args[] = {&a};
    hipError_t e = hipLaunchCooperativeKernel((const void*)mega_fwd, dim3(grid), dim3(512), args, LDS_BYTES, stream);
    if (e != hipSuccess) fprintf(stderr, "cooperative launch failed: %s (grid %d)\n", hipGetErrorString(e), grid);
}
```
